# Optimizing an MI355X kernel written in HIP

```python
import jax, jax.numpy as jnp
from jax import lax
import numpy as np

D_MODEL = 1024
BATCH = 16
SEQ = 2048
DEPTH = 2

GRID_W = 64
CTX_LEN = 256
EPS = 1e-6
ROPE_THETA = 10000.0
Q_BLOCK = 128
N_MOD = 6
N_BRANCH = 3
D_FF = 4 * D_MODEL
A_HEADS = 8
A_KV_HEADS = 2
A_GROUP = A_HEADS // A_KV_HEADS
A_HEAD_DIM = 64
B_HEADS = 4
B_KEY_DIM = 64
B_VAL_DIM = 128
B_GATE_RANK = 16
B_GATE_NORM = 16.0
B_CHUNK = 64
C_HEADS = 8
C_NOPE = 64
C_ROPE = 32
C_VDIM = 64
C_Q_RANK = 384
C_KV_RANK = 256
BRANCH_W = 512
IN_SPLITS = (A_HEADS * A_HEAD_DIM, A_KV_HEADS * A_HEAD_DIM, A_KV_HEADS * A_HEAD_DIM,
             B_HEADS * B_KEY_DIM, B_HEADS * B_KEY_DIM, B_HEADS * B_VAL_DIM, 2 * B_GATE_RANK, B_HEADS * B_VAL_DIM,
             C_Q_RANK, C_KV_RANK, C_ROPE, N_BRANCH * D_MODEL)
D_IN = sum(IN_SPLITS)

kernel_name = 'hybrid_parallel_mixer_dit_prefix'


def rms_norm(x, g):
    xf = x.astype(jnp.float32)
    y = xf * lax.rsqrt(jnp.mean(xf * xf, axis=-1, keepdims=True) + EPS)
    return (y * g.astype(jnp.float32)).astype(x.dtype)


def modulate(h, shift, scale):
    return h * (1.0 + scale) + shift


def axial_rope_tables(rows, rot_dim, dtype):
    row = jnp.repeat(jnp.arange(rows, dtype=jnp.float32), GRID_W)
    col = jnp.tile(jnp.arange(GRID_W, dtype=jnp.float32), rows)
    n_freq = rot_dim // 4
    inv_freq = ROPE_THETA ** (-jnp.arange(n_freq, dtype=jnp.float32) / n_freq)
    ang = jnp.concatenate([row[:, None] * inv_freq, col[:, None] * inv_freq], axis=-1)
    return jnp.cos(ang).astype(dtype), jnp.sin(ang).astype(dtype)


def apply_rope(x, cos, sin):
    xp = x.reshape(x.shape[:-1] + (-1, 2))
    x0, x1 = xp[..., 0], xp[..., 1]
    out = jnp.stack([x0 * cos - x1 * sin, x0 * sin + x1 * cos], axis=-1)
    return out.reshape(x.shape).astype(x.dtype)


def split_in(z):
    idx = np.cumsum(np.array(IN_SPLITS))[:-1].tolist()
    return jnp.split(z, idx, axis=-1)


def block_attention(q, k, v, scale):
    B, KVH, G, N, d = q.shape
    nb = N // Q_BLOCK
    qb = q.reshape(B, KVH, G, nb, Q_BLOCK, d).transpose(3, 0, 1, 2, 4, 5)

    def one_block(qi):
        s = jnp.einsum('bkgqd,bkmd->bkgqm', qi, k).astype(jnp.float32) * scale
        p = jax.nn.softmax(s, axis=-1).astype(v.dtype)
        return jnp.einsum('bkgqm,bkmd->bkgqd', p, v)

    o = lax.map(one_block, qb)
    return o.transpose(1, 2, 3, 0, 4, 5).reshape(B, KVH, G, N, v.shape[-1])


def merge_heads(o):
    B, K, G, N, d = o.shape
    return o.transpose(0, 3, 1, 2, 4).reshape(B, N, K * G * d)


def gqa_mixer(pl, pc, g_q, g_k, cos, sin, need_ctx):
    def heads(q, k, v):
        B, N, _ = q.shape
        q = q.reshape(B, N, A_KV_HEADS, A_GROUP, A_HEAD_DIM).transpose(0, 2, 3, 1, 4)
        k = k.reshape(B, N, A_KV_HEADS, A_HEAD_DIM).transpose(0, 2, 1, 3)
        v = v.reshape(B, N, A_KV_HEADS, A_HEAD_DIM).transpose(0, 2, 1, 3)
        return rms_norm(q, g_q), rms_norm(k, g_k), v

    q_l, k_l, v_l = heads(*pl)
    q_c, k_c, v_c = heads(*pc)
    q_l = apply_rope(q_l, cos, sin)
    k_l = apply_rope(k_l, cos, sin)
    k_all = jnp.concatenate([k_c, k_l], axis=2)
    v_all = jnp.concatenate([v_c, v_l], axis=2)
    scale = A_HEAD_DIM ** -0.5
    o_l = merge_heads(block_attention(q_l, k_all, v_all, scale))
    o_c = merge_heads(block_attention(q_c, k_c, v_c, scale)) if need_ctx else None
    return o_l, o_c


def gla_scan(q, k, v, log_a, s0):
    B, H, N, dk = q.shape
    dv = v.shape[-1]
    nc = N // B_CHUNK
    r = lambda t: t.reshape(B, H, nc, B_CHUNK, t.shape[-1])
    q, k, v, log_a = r(q), r(k), r(v), r(log_a)
    b = jnp.cumsum(log_a, axis=3)
    b_last = b[:, :, :, -1:, :]
    q_dec = q * jnp.exp(b)
    k_dec = k * jnp.exp(-b)
    k_to_end = k * jnp.exp(b_last - b)
    mask = jnp.tril(jnp.ones((B_CHUNK, B_CHUNK), dtype=bool))
    attn = jnp.where(mask, jnp.einsum('bhcid,bhcjd->bhcij', q_dec, k_dec), 0.0)
    o_intra = jnp.einsum('bhcij,bhcjv->bhciv', attn, v)
    u = jnp.einsum('bhcjd,bhcjv->bhcdv', k_to_end, v)
    g = jnp.exp(b_last[:, :, :, 0, :])

    def step(s, inp):
        g_c, u_c = inp
        return g_c[..., None] * s + u_c, s

    s_final, s_enter = lax.scan(step, s0, (g.transpose(2, 0, 1, 3), u.transpose(2, 0, 1, 3, 4)))
    s_enter = s_enter.transpose(1, 2, 0, 3, 4)
    o_inter = jnp.einsum('bhcid,bhcdv->bhciv', q_dec, s_enter)
    return (o_intra + o_inter).reshape(B, H, N, dv), s_final


def gla_bidir(q, k, v, la_f, la_b, s0_f, s0_b):
    o_f, s_f = gla_scan(q, k, v, la_f, s0_f)
    flip = lambda t: jnp.flip(t, axis=2)
    o_b, s_b = gla_scan(flip(q), flip(k), flip(v), flip(la_b), s0_b)
    return o_f + flip(o_b), s_f, s_b


def gla_mixer(pl, pc, w_alpha, b_alpha, g_out):
    def prep(q, k, v, a_lr):
        B, N, _ = q.shape
        heads = lambda t: t.reshape(B, N, B_HEADS, -1).transpose(0, 2, 1, 3).astype(jnp.float32)
        logits = jnp.einsum('bnzr,zrd->zbnd', a_lr.reshape(B, N, 2, B_GATE_RANK), w_alpha) + b_alpha[:, None, None, :]
        log_a = jax.nn.log_sigmoid(logits.astype(jnp.float32)) / B_GATE_NORM
        return heads(q) * (B_KEY_DIM ** -0.5), heads(k), heads(v), heads(log_a[0]), heads(log_a[1])

    q_c, k_c, v_c, lf_c, lb_c = prep(*pc[:4])
    s0 = jnp.zeros((q_c.shape[0], B_HEADS, B_KEY_DIM, B_VAL_DIM), jnp.float32)
    o_c, s_f, s_b = gla_bidir(q_c, k_c, v_c, lf_c, lb_c, s0, s0)
    q_l, k_l, v_l, lf_l, lb_l = prep(*pl[:4])
    o_l, _, _ = gla_bidir(q_l, k_l, v_l, lf_l, lb_l, s_f, s_b)

    def finish(o, gate):
        o = rms_norm(o.transpose(0, 2, 1, 3), g_out)
        B, N = o.shape[:2]
        return (o.reshape(B, N, -1) * jax.nn.silu(gate.astype(jnp.float32))).astype(gate.dtype)

    return finish(o_l, pl[4]), finish(o_c, pc[4])


def mla_mixer(pl, pc, g_cq, g_ckv, w_uq, w_ukv, cos, sin, need_ctx):
    def heads(cq, ckv, kr):
        B, N, _ = cq.shape
        q = (rms_norm(cq, g_cq) @ w_uq).reshape(B, N, C_HEADS, C_NOPE + C_ROPE).transpose(0, 2, 1, 3)
        kv = (rms_norm(ckv, g_ckv) @ w_ukv).reshape(B, N, C_HEADS, C_NOPE + C_VDIM).transpose(0, 2, 1, 3)
        return q, kv[..., :C_NOPE], kv[..., C_NOPE:], kr[:, None]

    def full_key(k_nope, k_rope):
        return jnp.concatenate([k_nope, jnp.broadcast_to(k_rope, k_nope.shape[:-1] + (C_ROPE,))], axis=-1)

    q_l, kn_l, v_l, kr_l = heads(*pl)
    q_c, kn_c, v_c, kr_c = heads(*pc)
    q_l = jnp.concatenate([q_l[..., :C_NOPE], apply_rope(q_l[..., C_NOPE:], cos, sin)], axis=-1)
    k_l = full_key(kn_l, apply_rope(kr_l, cos, sin))
    k_c = full_key(kn_c, kr_c)
    k_all = jnp.concatenate([k_c, k_l], axis=2)
    v_all = jnp.concatenate([v_c, v_l], axis=2)
    scale = (C_NOPE + C_ROPE) ** -0.5
    o_l = merge_heads(block_attention(q_l[:, :, None], k_all, v_all, scale))
    o_c = merge_heads(block_attention(q_c[:, :, None], k_c, v_c, scale)) if need_ctx else None
    return o_l, o_c


def merge_branches(outs, gate_logits, w_branch, w_out):
    B, N, _ = gate_logits.shape
    gates = jax.nn.sigmoid(gate_logits).reshape(B, N, N_BRANCH, D_MODEL)
    branch = jnp.stack(outs, axis=2)
    proj = jnp.einsum('bnzw,zwd->bnzd', branch, w_branch)
    return jnp.sum(gates * proj, axis=2) @ w_out


def mixing_sublayer(h_lat, h_ctx, w_in, a_g_q, a_g_k, b_w_alpha, b_b_alpha, b_g_out,
                    c_g_q, c_g_kv, c_w_uq, c_w_ukv, w_branch, w_out, rope_a, rope_c, need_ctx):
    pl = split_in(h_lat @ w_in)
    pc = split_in(h_ctx @ w_in)
    oa_l, oa_c = gqa_mixer(pl[0:3], pc[0:3], a_g_q, a_g_k, rope_a[0], rope_a[1], need_ctx)
    ob_l, ob_c = gla_mixer(pl[3:8], pc[3:8], b_w_alpha, b_b_alpha, b_g_out)
    oc_l, oc_c = mla_mixer(pl[8:11], pc[8:11], c_g_q, c_g_kv, c_w_uq, c_w_ukv, rope_c[0], rope_c[1], need_ctx)
    y_lat = merge_branches((oa_l, ob_l, oc_l), pl[11], w_branch, w_out)
    y_ctx = merge_branches((oa_c, ob_c, oc_c), pc[11], w_branch, w_out) if need_ctx else None
    return y_lat, y_ctx


def sq_relu_mlp(h, w1, w2):
    return jnp.square(jax.nn.relu(h @ w1)) @ w2


def setup_inputs(seed: int = 0) -> dict:
    key = jax.random.key(seed)
    ks = jax.random.split(key, 24)
    L = DEPTH

    def nrm(k, shape, scale):
        return jax.random.normal(k, shape, jnp.float32) * scale

    def gain(k, shape):
        return 1.0 + 0.05 * jax.random.normal(k, shape, jnp.float32)

    return {
        'x': nrm(ks[0], (BATCH, SEQ, D_MODEL), 1.0),
        'c': nrm(ks[1], (BATCH, D_MODEL), 1.0),
        'ctx': nrm(ks[2], (BATCH, CTX_LEN, D_MODEL), 1.0),
        'c_ctx': nrm(ks[3], (D_MODEL,), 1.0),
        'w_ada': nrm(ks[4], (L, D_MODEL, N_MOD * D_MODEL), 0.5 * D_MODEL ** -0.5),
        'b_ada': nrm(ks[5], (L, N_MOD * D_MODEL), 0.01),
        'g_pre_attn': gain(ks[6], (L, D_MODEL)),
        'g_post_attn': gain(ks[7], (L, D_MODEL)),
        'g_pre_mlp': gain(ks[8], (L, D_MODEL)),
        'g_post_mlp': gain(ks[9], (L, D_MODEL)),
        'w_in': nrm(ks[10], (L, D_MODEL, D_IN), D_MODEL ** -0.5),
        'a_g_q': gain(ks[11], (L, A_HEAD_DIM)),
        'a_g_k': gain(ks[12], (L, A_HEAD_DIM)),
        'b_w_alpha': nrm(ks[13], (L, 2, B_GATE_RANK, B_HEADS * B_KEY_DIM), B_GATE_RANK ** -0.5),
        'b_b_alpha': nrm(ks[14], (L, 2, B_HEADS * B_KEY_DIM), 0.1),
        'b_g_out': gain(ks[15], (L, B_VAL_DIM)),
        'c_g_q': gain(ks[16], (L, C_Q_RANK)),
        'c_g_kv': gain(ks[17], (L, C_KV_RANK)),
        'c_w_uq': nrm(ks[18], (L, C_Q_RANK, C_HEADS * (C_NOPE + C_ROPE)), C_Q_RANK ** -0.5),
        'c_w_ukv': nrm(ks[19], (L, C_KV_RANK, C_HEADS * (C_NOPE + C_VDIM)), C_KV_RANK ** -0.5),
        'w_branch': nrm(ks[20], (L, N_BRANCH, BRANCH_W, D_MODEL), BRANCH_W ** -0.5),
        'w_out': nrm(ks[21], (L, D_MODEL, D_MODEL), D_MODEL ** -0.5),
        'w_mlp_in': nrm(ks[22], (L, D_MODEL, D_FF), D_MODEL ** -0.5),
        'w_mlp_out': nrm(ks[23], (L, D_FF, D_MODEL), D_FF ** -0.5),
    }


def reference(x, c, ctx, c_ctx, w_ada, b_ada, g_pre_attn, g_post_attn, g_pre_mlp, g_post_mlp,
              w_in, a_g_q, a_g_k, b_w_alpha, b_b_alpha, b_g_out, c_g_q, c_g_kv, c_w_uq, c_w_ukv,
              w_branch, w_out, w_mlp_in, w_mlp_out):
    n_lat = x.shape[1]
    rows = n_lat // GRID_W
    rope_a = axial_rope_tables(rows, A_HEAD_DIM, x.dtype)
    rope_c = axial_rope_tables(rows, C_ROPE, x.dtype)
    xc = ctx
    for l in range(DEPTH):
        need_ctx = l < DEPTH - 1
        mod_lat = (jax.nn.silu(c) @ w_ada[l] + b_ada[l])[:, None, :]
        mod_ctx = jax.nn.silu(c_ctx) @ w_ada[l] + b_ada[l]
        sh1, sc1, gt1, sh2, sc2, gt2 = jnp.split(mod_lat, N_MOD, axis=-1)
        csh1, csc1, cgt1, csh2, csc2, cgt2 = jnp.split(mod_ctx, N_MOD, axis=-1)
        h_lat = modulate(rms_norm(x, g_pre_attn[l]), sh1, sc1)
        h_ctx = modulate(rms_norm(xc, g_pre_attn[l]), csh1, csc1)
        y_lat, y_ctx = mixing_sublayer(h_lat, h_ctx, w_in[l], a_g_q[l], a_g_k[l], b_w_alpha[l], b_b_alpha[l],
                                       b_g_out[l], c_g_q[l], c_g_kv[l], c_w_uq[l], c_w_ukv[l],
                                       w_branch[l], w_out[l], rope_a, rope_c, need_ctx)
        x = x + gt1 * rms_norm(y_lat, g_post_attn[l])
        f_lat = sq_relu_mlp(modulate(rms_norm(x, g_pre_mlp[l]), sh2, sc2), w_mlp_in[l], w_mlp_out[l])
        x = x + gt2 * rms_norm(f_lat, g_post_mlp[l])
        if need_ctx:
            xc = xc + cgt1 * rms_norm(y_ctx, g_post_attn[l])
            f_ctx = sq_relu_mlp(modulate(rms_norm(xc, g_pre_mlp[l]), csh2, csc2), w_mlp_in[l], w_mlp_out[l])
            xc = xc + cgt2 * rms_norm(f_ctx, g_post_mlp[l])
    return x
```

```cpp
#include <hip/hip_runtime.h>
#include <hip/hip_cooperative_groups.h>
#include <cstdio>
#include <cstdint>
namespace cg = cooperative_groups;

#define LAS __attribute__((address_space(3)))
typedef unsigned short bf16_t;
typedef short bf16x8 __attribute__((ext_vector_type(8)));
typedef short s16x4 __attribute__((ext_vector_type(4)));
typedef float f32x4 __attribute__((ext_vector_type(4)));
typedef unsigned u32x4 __attribute__((ext_vector_type(4)));
typedef unsigned u32x2 __attribute__((ext_vector_type(2)));

constexpr int D = 1024, NB = 16, NLAT = 2048, NCTX = 256, RB = NLAT + NCTX, R = NB * RB;
constexpr int DIN = 6080, DFF = 4096;
constexpr float EPS = 1e-6f;
constexpr float LOG2E = 1.4426950408889634f;
constexpr float L2THETA = 13.287712379549449f;

constexpr size_t MiB = 1u << 20;
constexpr size_t WS_CTL = 0;
constexpr size_t WS_MOD = 1 * MiB;
constexpr size_t WS_WIN = 2 * MiB;
constexpr size_t WS_WUQ = 8 * MiB;
constexpr size_t WS_WUKV = 9 * MiB;
constexpr size_t WS_WMG = 10 * MiB;
constexpr size_t WS_WOUT = 19 * MiB;
constexpr size_t WS_XC = 21 * MiB;
constexpr size_t WS_STATS = 37 * MiB;
constexpr size_t WS_LR = 43 * MiB;
constexpr size_t WS_HB = 48 * MiB;
constexpr size_t WS_MB = 192 * MiB;
constexpr size_t WS_ZA = 336 * MiB;
constexpr size_t WS_ZB = 390 * MiB;
constexpr size_t WS_HID = 192 * MiB;
constexpr size_t WS_WM1 = 480 * MiB;
constexpr size_t WS_WM2 = 488 * MiB;
constexpr size_t WS_END = 498 * MiB;
constexpr int HBP = 2048, MBP = 2048, ZAP = 768, ZBP = 1536, HIDP = 4096;

struct Params { const float* in[24]; float* out; unsigned char* ws; };

typedef float f32x2_t __attribute__((ext_vector_type(2))); typedef __bf16 bf16x2_t __attribute__((ext_vector_type(2)));
__device__ __forceinline__ unsigned cvt_pk_bf16(float lo, float hi) { const f32x2_t v = {lo, hi}; const bf16x2_t b = __builtin_convertvector(v, bf16x2_t); return __builtin_bit_cast(unsigned, b); }
__device__ __forceinline__ float bf2f(unsigned short v) { return __uint_as_float(((unsigned)v) << 16); }
__device__ __forceinline__ float bflo(unsigned v) { return __uint_as_float(v << 16); }
__device__ __forceinline__ float bfhi(unsigned v) { return __uint_as_float(v & 0xffff0000u); }
__device__ __forceinline__ float max3f(float a, float b, float c) { return __builtin_fmaxf(__builtin_fmaxf(a, b), c); }
__device__ __forceinline__ float wave_sum(float v) {
#pragma unroll
    for (int o = 1; o < 64; o <<= 1) v += __shfl_xor(v, o);
    return v;
}
#define LDS_WAIT() asm volatile("s_waitcnt lgkmcnt(0)" ::: "memory")
#define XB_TMO      128
#define XB_XCNT(j)  (256  + 64 * (j))
#define XB_XSUB(j)  (1280 + 64 * (j))
#define XB_XGEN(j)  (2304 + 64 * (j))
#define XB_TOP      3328
#define XB_TOPGEN   3392
#define XCD_BAR_WORDS 3456
#define XB_SPIN_CAP (1u << 20)
__device__ __forceinline__ unsigned xb_ld(unsigned* p)              { return __hip_atomic_load(p, __ATOMIC_RELAXED, __HIP_MEMORY_SCOPE_AGENT); }
__device__ __forceinline__ unsigned xb_add(unsigned* p, unsigned v) { return __hip_atomic_fetch_add(p, v, __ATOMIC_RELAXED, __HIP_MEMORY_SCOPE_AGENT); }
__device__ __forceinline__ unsigned xb_xcc_id() { return (unsigned)__builtin_amdgcn_s_getreg((3 << 11) | 20) & 0xFu; }
#define XB_SPIN(cond, bar) do { unsigned _sp = 0; while (cond) { __builtin_amdgcn_s_sleep(1); \
    if ((++_sp & 255u) == 0u) { if (xb_ld(&(bar)[XB_TMO])) break; if (_sp > XB_SPIN_CAP) { atomicAdd(&(bar)[XB_TMO], 1u); break; } } } } while (0)
__device__ __forceinline__ void xcd_barrier_complete(unsigned* bar, unsigned x, unsigned& nloc, unsigned& nx) {
    const unsigned G = gridDim.x * gridDim.y * gridDim.z;
    unsigned sum, cnt, mine, sp = 0u;
    for (;;) {
        sum = 0u; cnt = 0u; mine = 0u;
#pragma unroll
        for (unsigned j = 0; j < 16; ++j) { const unsigned c = xb_ld(&bar[XB_XCNT(j)]); sum += c; cnt += (c > 0u) ? 1u : 0u; mine = (j == x) ? c : mine; }
        if (sum == G) break;
        __builtin_amdgcn_s_sleep(1);
        if ((++sp & 255u) == 0u) { if (xb_ld(&bar[XB_TMO])) break; if (sp > XB_SPIN_CAP) { atomicAdd(&bar[XB_TMO], 1u); break; } }
    }
    nloc = mine > 0u ? mine : 1u; nx = cnt > 0u ? cnt : 1u;
}
__device__ __forceinline__ void xcd_barrier(unsigned* bar, unsigned x, volatile LAS unsigned* st) {
    asm volatile("s_waitcnt vmcnt(0) lgkmcnt(0)" ::: "memory");
    __syncthreads();
    if (threadIdx.x == 0) {
        __builtin_amdgcn_s_waitcnt(0);
        unsigned nloc = st[0], nx = st[1];
        if (nloc == 0u) { xcd_barrier_complete(bar, x, nloc, nx); st[0] = nloc; st[1] = nx; }
        const unsigned old = xb_add(&bar[XB_XSUB(x)], 1u);
        const unsigned gen = old / nloc;
        if (old + 1u == (gen + 1u) * nloc) {
            __builtin_amdgcn_fence(__ATOMIC_RELEASE, "agent");
            asm volatile("s_waitcnt vmcnt(0)" ::: "memory");
            const unsigned og = xb_add(&bar[XB_TOP], 1u);
            const unsigned tg = og / nx;
            if (og + 1u == (tg + 1u) * nx) xb_add(&bar[XB_TOPGEN], 1u);
            else XB_SPIN(xb_ld(&bar[XB_TOPGEN]) == tg, bar);
            __builtin_amdgcn_fence(__ATOMIC_ACQUIRE, "agent");
            xb_add(&bar[XB_XGEN(x)], 1u);
            asm volatile("s_waitcnt vmcnt(0)" ::: "memory");
        } else {
            XB_SPIN(xb_ld(&bar[XB_XGEN(x)]) == gen, bar);
            __builtin_amdgcn_fence(__ATOMIC_ACQUIRE, "agent");
            asm volatile("s_waitcnt vmcnt(0)" ::: "memory");
        }
    }
    __syncthreads();
}
__device__ __forceinline__ void grid_bar(unsigned* cnt, unsigned& gen) {
    asm volatile("s_waitcnt vmcnt(0) lgkmcnt(0)" ::: "memory");
    __syncthreads();
    gen += 1;
    if (threadIdx.x == 0) {
        __builtin_amdgcn_fence(__ATOMIC_RELEASE, "agent");
        asm volatile("s_waitcnt vmcnt(0)" ::: "memory");
        __hip_atomic_fetch_add(cnt, 1u, __ATOMIC_RELAXED, __HIP_MEMORY_SCOPE_AGENT);
        const unsigned target = gen * gridDim.x;
        while (__hip_atomic_load(cnt, __ATOMIC_RELAXED, __HIP_MEMORY_SCOPE_AGENT) < target) __builtin_amdgcn_s_sleep(1);
        __builtin_amdgcn_fence(__ATOMIC_ACQUIRE, "agent");
        asm volatile("s_waitcnt vmcnt(0)" ::: "memory");
    }
    __syncthreads();
}

namespace pg8 {
constexpr int BM = 256, BK = 64, HALF = 128, HTB = HALF * BK * 2, STAGE_BYTES = 8 * HTB;
__device__ __forceinline__ int lds_byte(int r, int c) { const int st = (r >> 4) * 2 + (c >> 5), rr = r & 15, cc = c & 31, ob = rr * 64 + cc * 2; return st * 1024 + (ob ^ (((ob >> 9) & 1) << 5)); }
__device__ __forceinline__ void stage_rc(int b, int& R_, int& C_) { const int st = b / 1024, sb = b % 1024, swz = sb ^ (((sb >> 9) & 1) << 5); R_ = (st >> 1) * 16 + swz / 64; C_ = (st & 1) * 32 + (swz % 64) / 2; }
__device__ __forceinline__ int perm32(int rho) { const int n = rho >> 4, i = rho & 15; return 8 * (i >> 2) + 4 * n + (i & 3); }

struct Unit { const char* a; const char* b; int nt; int pm, pn, kind; };
typedef f32x4 Acc[2][2][4][2];
__device__ __forceinline__ void zero_acc(Acc& acc) {
#pragma unroll
    for (int a = 0; a < 2; ++a)
#pragma unroll
        for (int b = 0; b < 2; ++b)
#pragma unroll
            for (int m = 0; m < 4; ++m)
#pragma unroll
                for (int n = 0; n < 2; ++n) acc[a][b][m][n] = (f32x4){0.f, 0.f, 0.f, 0.f};
}

template <class Epi, class Sched>
__device__ __forceinline__ void gemm_phase(LAS unsigned char* lds, const int lda, const int ldb, const Sched& S, const Epi& E) {
    int tid_ = threadIdx.x; asm volatile("" : "+v"(tid_));
    const int tid = tid_, wid = __builtin_amdgcn_readfirstlane(tid >> 6), lane = tid & 63, wr = wid >> 2, wc = wid & 3, fr = lane & 15, fq = lane >> 4;
    unsigned voffA[2], voffB[2];
#pragma unroll
    for (int i = 0; i < 2; ++i) { int R_, C_; stage_rc(tid * 16 + i * 8192, R_, C_); const int Rb = (R_ & ~31) + perm32(R_ & 31);
        voffA[i] = (unsigned)(R_ * lda + C_) * 2u; voffB[i] = (unsigned)(Rb * ldb + C_) * 2u; }
    const size_t kstep = (size_t)(BK * 2);
    const size_t hstepA = (size_t)HALF * lda * 2, hstepB = (size_t)HALF * ldb * 2;
    const unsigned ldsw = (unsigned)wid * 1024u;
    const int aoff = lds_byte(wr * 64 + fr, fq * 8), boff = lds_byte(wc * 32 + fr, fq * 8);
#define PG8_SA(b, h) (((b) * 2 + (h)) * HTB)
#define PG8_SB(b, h) ((4 + (b) * 2 + (h)) * HTB)
#define PG8_STAGE(bufoff, gbase, voff) do { _Pragma("unroll") for (int _i = 0; _i < 2; ++_i) \
        __builtin_amdgcn_global_load_lds((const unsigned*)((const char*)(gbase) + (voff)[_i]), (LAS unsigned*)(lds + (bufoff) + ldsw + _i * 8192), 16, 0, 0); } while (0)
#define PG8_LDA(dst, b, h) do { _Pragma("unroll") for (int m = 0; m < 4; ++m) _Pragma("unroll") for (int k = 0; k < 2; ++k) dst[m][k] = *(const LAS bf16x8*)(lds + PG8_SA(b, h) + aoff + m * 2048 + k * 1024); } while (0)
#define PG8_LDB(dst, b, h) do { _Pragma("unroll") for (int n = 0; n < 2; ++n) _Pragma("unroll") for (int k = 0; k < 2; ++k) dst[n][k] = *(const LAS bf16x8*)(lds + PG8_SB(b, h) + boff + n * 2048 + k * 1024); } while (0)
#define PG8_MMA(ai, bj, At, Bt) do { __builtin_amdgcn_s_setprio(1); _Pragma("unroll") for (int m = 0; m < 4; ++m) _Pragma("unroll") for (int n = 0; n < 2; ++n) _Pragma("unroll") for (int k = 0; k < 2; ++k) \
        acc[ai][bj][m][n] = __builtin_amdgcn_mfma_f32_16x16x32_bf16(Bt[n][k], At[m][k], acc[ai][bj][m][n], 0, 0, 0); __builtin_amdgcn_s_setprio(0); } while (0)
#define PG8_WAIT_V(n) asm volatile("s_waitcnt vmcnt(" #n ")" ::: "memory")
#define PG8_WAIT_L(n) asm volatile("s_waitcnt lgkmcnt(" #n ")" ::: "memory")
#define PG8_BAR __builtin_amdgcn_s_barrier()
#define PG8_SCHED __builtin_amdgcn_sched_barrier(0)
    Unit cur, nxt; int ui = 0;
    if (!S.next(0, cur)) return;
    Acc acc; zero_acc(acc);
    bf16x8 At[4][2], B0[2][2], B1[2][2];
    const char* cA = cur.a; const char* cB = cur.b;
    PG8_STAGE(PG8_SB(0, 0), cB, voffB); PG8_STAGE(PG8_SB(0, 1), cB + hstepB, voffB); PG8_STAGE(PG8_SA(0, 0), cA, voffA); PG8_STAGE(PG8_SA(0, 1), cA + hstepA, voffA);
    if (wr == 1) PG8_BAR;
    PG8_WAIT_V(2); PG8_BAR;
    PG8_STAGE(PG8_SB(1, 0), cB + kstep, voffB); PG8_STAGE(PG8_SA(1, 0), cA + kstep, voffA); PG8_STAGE(PG8_SB(1, 1), cB + hstepB + kstep, voffB);
    PG8_WAIT_V(6); PG8_BAR;
    for (;;) {
        const bool has_next = S.next(ui + 1, nxt);
        const char* nA = has_next ? nxt.a : cA; const char* nB = has_next ? nxt.b : cB;
        const int nt = cur.nt;
        for (int t = 0; t < nt; t += 2) {
            const bool last = (t == nt - 2);
            const char* a1 = cA + (size_t)(t + 1) * kstep;
            const char* a2 = last ? nA : cA + (size_t)(t + 2) * kstep; const char* b2 = last ? nB : cB + (size_t)(t + 2) * kstep;
            const char* a3 = a2 + kstep; const char* b3 = b2 + kstep;
            PG8_LDB(B0, 0, 0); PG8_LDB(B1, 0, 1); PG8_SCHED; PG8_LDA(At, 0, 0); PG8_STAGE(PG8_SA(1, 1), a1 + hstepA, voffA);
            PG8_WAIT_V(8); PG8_WAIT_L(0); PG8_BAR; PG8_MMA(0, 0, At, B0); PG8_MMA(0, 1, At, B1); PG8_BAR; PG8_SCHED;
            PG8_LDA(At, 0, 1); PG8_STAGE(PG8_SB(0, 0), b2, voffB); PG8_STAGE(PG8_SB(0, 1), b2 + hstepB, voffB); PG8_STAGE(PG8_SA(0, 0), a2, voffA);
            PG8_WAIT_V(8); PG8_WAIT_L(0); PG8_BAR; PG8_MMA(1, 0, At, B0); PG8_MMA(1, 1, At, B1); PG8_BAR; PG8_SCHED;
            PG8_LDB(B0, 1, 0); PG8_LDB(B1, 1, 1); PG8_SCHED; PG8_LDA(At, 1, 0); PG8_STAGE(PG8_SA(0, 1), a2 + hstepA, voffA);
            PG8_WAIT_V(8); PG8_WAIT_L(0); PG8_BAR; PG8_MMA(0, 0, At, B0); PG8_MMA(0, 1, At, B1); PG8_BAR; PG8_SCHED;
            PG8_LDA(At, 1, 1); PG8_STAGE(PG8_SB(1, 0), b3, voffB); PG8_STAGE(PG8_SB(1, 1), b3 + hstepB, voffB); PG8_STAGE(PG8_SA(1, 0), a3, voffA);
            PG8_WAIT_V(8); PG8_WAIT_L(0); PG8_BAR; PG8_MMA(1, 0, At, B0); PG8_MMA(1, 1, At, B1); PG8_BAR; PG8_SCHED;
        }
        if (wr == 0) PG8_BAR;
        E(acc, cur, wr, wc, fr, fq);
        if (!has_next) break;
        cur = nxt; cA = nA; cB = nB; ++ui;
        if (wr == 1) PG8_BAR;
    }
    PG8_WAIT_V(0);
    PG8_BAR;
#undef PG8_SA
#undef PG8_SB
#undef PG8_STAGE
#undef PG8_LDA
#undef PG8_LDB
#undef PG8_MMA
#undef PG8_WAIT_V
#undef PG8_WAIT_L
#undef PG8_BAR
#undef PG8_SCHED
}
}

struct Sched {
    const char* A; const char* B; size_t a_tile, b_tile;
    int nM, nN, nt, G, c, mode, skip_ctx;
    const char* A2; const char* A3; const char* A4;
    __device__ __forceinline__ int map_pm(int pm) const { return skip_ctx ? (pm >> 3) * 9 + 1 + (pm & 7) : pm; }
    __device__ __forceinline__ bool next(int i, pg8::Unit& u) const {
        if (mode == 0) {
            const int nwg = nM * nN; const long L = (long)i * G + c; if (L >= nwg) return false;
            int wgid = (int)L; { const int q = nwg / 8, r = nwg % 8, xcd = wgid % 8, off = wgid / 8; wgid = (xcd < r ? xcd * (q + 1) : r * (q + 1) + (xcd - r) * q) + off; }
            const int nig = 8 * nN, gid = wgid / nig, fm = gid * 8, gsz = (nM - fm) < 8 ? (nM - fm) : 8;
            const int pm = map_pm(fm + ((wgid % nig) % gsz)), pn = (wgid % nig) / gsz;
            u.pm = pm; u.pn = pn; u.kind = 0; u.nt = nt; u.a = A + (size_t)pm * a_tile; u.b = B + (size_t)pn * b_tile; return true;
        } else if (mode == 1) {
            const long L = (long)i * G + c; if (L >= 144 * 7) return false;
            const int pm = (int)(L / 7), s = (int)(L % 7);
            u.pm = pm;
            if (s < 3) { u.kind = 0; u.pn = s; u.nt = 6; u.a = A + (size_t)pm * a_tile; u.b = B + (size_t)s * b_tile; }
            else { u.kind = 1; u.pn = s - 3; u.nt = 4; u.a = A2 + (size_t)pm * a_tile; u.b = (const char*)A3 + (size_t)(s - 3) * b_tile; }
            return true;
        } else {
            const int ntile = nM * 4; const long L = (long)(i / 6) * G + c; if (L >= ntile) return false;
            const int sub = i % 6; const int pm = map_pm((int)(L >> 2)), pn = (int)(L & 3);
            u.pm = pm; u.pn = pn; u.kind = sub;
            const int z = sub >> 1;
            const char* bb = B + ((size_t)z * 1024 + (size_t)pn * 256) * 1536 * 2;
            if ((sub & 1) == 0) { u.a = A + (size_t)pm * a_tile; u.b = bb; u.nt = 16; }
            else { const char* ab = (z == 2) ? A4 : A2 + (size_t)z * 1024; u.a = ab + (size_t)pm * a_tile; u.b = bb + 1024 * 2; u.nt = 8; }
            return true;
        }
    }
};

__device__ __forceinline__ void row_info(int r, int& b, int& j) { b = r / RB; j = r - b * RB; }

template <int MODE> struct EpiStore {
    unsigned char* ws; bf16_t* dst; int dpitch; float* stats;
    __device__ __forceinline__ void operator()(pg8::Acc& acc, const pg8::Unit& u, int wr, int wc, int fr, int fq) const {
        const int row0 = u.pm * 256 + wr * 64 + fr;
#pragma unroll
        for (int bj = 0; bj < 2; ++bj) {
            const int n0 = u.pn * 256 + bj * 128 + wc * 32;
            bf16_t* base; int pitch; int sidx = -1; float* lrp = nullptr;
            if (MODE == 0) {
                if (n0 < 768) { base = (bf16_t*)(ws + WS_ZA) + n0; pitch = ZAP; if (n0 < 640) sidx = n0 >> 5; }
                else if (n0 < 2304) { base = (bf16_t*)(ws + WS_ZB) + (n0 - 768); pitch = ZBP; }
                else if (n0 < 2944) { base = (bf16_t*)(ws + WS_HB) + 1024 + (n0 - 2304); pitch = HBP; sidx = (n0 >> 5) - 52; }
                else if (n0 == 2944) { base = (bf16_t*)(ws + WS_MB) + 1792; pitch = MBP; }
                else if (n0 == 2976) { base = nullptr; pitch = 0; lrp = (float*)(ws + WS_LR); }
                else { base = nullptr; pitch = 0; }
            } else { base = dst + n0; pitch = dpitch; sidx = n0 >> 5; }
#pragma unroll
            for (int ai = 0; ai < 2; ++ai)
#pragma unroll
                for (int m = 0; m < 4; ++m) {
                    const int row = row0 + ai * 128 + m * 16;
                    f32x4 v0 = acc[ai][bj][m][0], v1 = acc[ai][bj][m][1];
                    if (MODE == 2) {
#pragma unroll
                        for (int e = 0; e < 4; ++e) { float a = fmaxf(v0[e], 0.f), b = fmaxf(v1[e], 0.f); v0[e] = a * a; v1[e] = b * b; }
                    }
                    if (MODE != 2) {
                        if (sidx >= 0) {
                            float s = (v0[0] * v0[0] + v0[1] * v0[1]) + (v0[2] * v0[2] + v0[3] * v0[3]) + (v1[0] * v1[0] + v1[1] * v1[1]) + (v1[2] * v1[2] + v1[3] * v1[3]);
                            s += __shfl_xor(s, 16); s += __shfl_xor(s, 32);
                            if (fq == 0) stats[(size_t)row * (MODE == 0 ? 40 : 32) + sidx] = s;
                        }
                    }
                    if (base) {
                        u32x4 w; w.x = cvt_pk_bf16(v0[0], v0[1]); w.y = cvt_pk_bf16(v0[2], v0[3]); w.z = cvt_pk_bf16(v1[0], v1[1]); w.w = cvt_pk_bf16(v1[2], v1[3]);
                        *(u32x4*)(base + (size_t)row * pitch + 8 * fq) = w;
                    } else if (MODE == 0 && lrp) {
                        float* o = lrp + (size_t)row * 32 + 8 * fq; *(f32x4*)o = v0; *(f32x4*)(o + 4) = v1;
                    }
                    asm volatile("" ::: "memory");
                }
        }
        pg8::zero_acc(acc);
    }
};

struct EpiUp {
    unsigned char* ws;
    __device__ __forceinline__ void operator()(pg8::Acc& acc, const pg8::Unit& u, int wr, int wc, int fr, int fq) const {
        const int row0 = u.pm * 256 + wr * 64 + fr;
        const float* stats = (const float*)(ws + WS_STATS);
        bf16_t* mb = (bf16_t*)(ws + WS_MB);
        const float qs = 0.10206207261596577f * LOG2E;
#pragma unroll
        for (int ai = 0; ai < 2; ++ai)
#pragma unroll
            for (int m = 0; m < 4; ++m) {
                const int row = row0 + ai * 128 + m * 16;
                const float* sp = stats + (size_t)row * 40 + (u.kind == 0 ? 20 : 32);
                float ss; float rs;
                if (u.kind == 0) { f32x4 a = *(const f32x4*)sp, b = *(const f32x4*)(sp + 4), c = *(const f32x4*)(sp + 8);
                    ss = (a[0] + a[1] + a[2] + a[3]) + (b[0] + b[1] + b[2] + b[3]) + (c[0] + c[1] + c[2] + c[3]); rs = rsqrtf(ss * (1.f / 384.f) + EPS) * qs; }
                else { f32x4 a = *(const f32x4*)sp, b = *(const f32x4*)(sp + 4); ss = (a[0] + a[1] + a[2] + a[3]) + (b[0] + b[1] + b[2] + b[3]); rs = rsqrtf(ss * (1.f / 256.f) + EPS); }
                int bb, jj; row_info(row, bb, jj);
                const bool lat = jj >= NCTX; const int tkn = jj - NCTX; const float grow = (float)(tkn >> 6), gcol = (float)(tkn & 63);
#pragma unroll
                for (int bj = 0; bj < 2; ++bj) {
                    const int n = u.pn * 256 + bj * 128 + wc * 32 + 8 * fq;
                    f32x4 v0 = acc[ai][bj][m][0] * rs, v1 = acc[ai][bj][m][1] * rs;
                    if (u.kind == 0 && n >= 512 && lat) {
                        const int e0 = (n - 512) & 31;
#pragma unroll
                        for (int pp = 0; pp < 4; ++pp) {
                            const int i = (e0 >> 1) + pp; const float pos = (i < 8) ? grow : gcol; const int f = i & 7;
                            float rev = pos * exp2f(-(float)f * (L2THETA / 8.f)) * 0.15915494309189535f; rev -= rintf(rev);
                            const float sn = __builtin_amdgcn_sinf(rev), cs = __builtin_amdgcn_cosf(rev);
                            float x0, x1;
                            if (pp == 0) { x0 = v0[0]; x1 = v0[1]; } else if (pp == 1) { x0 = v0[2]; x1 = v0[3]; } else if (pp == 2) { x0 = v1[0]; x1 = v1[1]; } else { x0 = v1[2]; x1 = v1[3]; }
                            const float y0 = x0 * cs - x1 * sn, y1 = x0 * sn + x1 * cs;
                            if (pp == 0) { v0[0] = y0; v0[1] = y1; } else if (pp == 1) { v0[2] = y0; v0[3] = y1; } else if (pp == 2) { v1[0] = y0; v1[1] = y1; } else { v1[2] = y0; v1[3] = y1; }
                        }
                    }
                    u32x4 w; w.x = cvt_pk_bf16(v0[0], v0[1]); w.y = cvt_pk_bf16(v0[2], v0[3]); w.z = cvt_pk_bf16(v1[0], v1[1]); w.w = cvt_pk_bf16(v1[2], v1[3]);
                    *(u32x4*)(mb + (size_t)row * MBP + (u.kind == 0 ? 1024 : 0) + n) = w;
                }
                asm volatile("" ::: "memory");
            }
        pg8::zero_acc(acc);
    }
};

struct EpiMerge {
    unsigned char* ws;
    __device__ __forceinline__ void operator()(pg8::Acc& acc, const pg8::Unit& u, int wr, int wc, int fr, int fq) const {
        u32x4* scr = (u32x4*)(ws + WS_ZB) + (size_t)blockIdx.x * (16 * 512) + threadIdx.x;
        const int z = u.kind >> 1;
        if ((u.kind & 1) == 0) {
            u32x4* sp = scr;
#pragma unroll
            for (int ai = 0; ai < 2; ++ai)
#pragma unroll
                for (int m = 0; m < 4; ++m)
#pragma unroll
                    for (int bj = 0; bj < 2; ++bj) {
                        float g[8];
#pragma unroll
                        for (int e = 0; e < 4; ++e) { g[e] = __builtin_amdgcn_rcpf(1.f + __expf(-acc[ai][bj][m][0][e])); g[4 + e] = __builtin_amdgcn_rcpf(1.f + __expf(-acc[ai][bj][m][1][e])); }
                        u32x4 w; w.x = cvt_pk_bf16(g[0], g[1]); w.y = cvt_pk_bf16(g[2], g[3]); w.z = cvt_pk_bf16(g[4], g[5]); w.w = cvt_pk_bf16(g[6], g[7]);
                        *sp = w; sp += 512; asm volatile("" : "+v"(sp) :: "memory");
                    }
        } else {
            const int row0 = u.pm * 256 + wr * 64 + fr;
            bf16_t* mo = (bf16_t*)(ws + WS_MB) + (size_t)row0 * MBP + u.pn * 256 + wc * 32 + 8 * fq;
            const u32x4* pa = scr;
#pragma unroll
            for (int g4 = 0; g4 < 4; ++g4) {
                u32x4 gv[4], mv[4];
#pragma unroll
                for (int k = 0; k < 4; ++k) { const int e = g4 * 4 + k, ai = e >> 3, m = (e >> 1) & 3, bj = e & 1;
                    gv[k] = __builtin_nontemporal_load(pa + k * 512);
                    if (z > 0) mv[k] = __builtin_nontemporal_load((const u32x4*)(mo + (size_t)(ai * 128 + m * 16) * MBP + bj * 128)); }
#pragma unroll
                for (int k = 0; k < 4; ++k) { const int e = g4 * 4 + k, ai = e >> 3, m = (e >> 1) & 3, bj = e & 1;
                    const f32x4 n0 = {bflo(gv[k].x), bfhi(gv[k].x), bflo(gv[k].y), bfhi(gv[k].y)}, n1 = {bflo(gv[k].z), bfhi(gv[k].z), bflo(gv[k].w), bfhi(gv[k].w)};
                    f32x4 v0 = acc[ai][bj][m][0] * n0, v1 = acc[ai][bj][m][1] * n1;
                    if (z > 0) { v0 += (f32x4){bflo(mv[k].x), bfhi(mv[k].x), bflo(mv[k].y), bfhi(mv[k].y)}; v1 += (f32x4){bflo(mv[k].z), bfhi(mv[k].z), bflo(mv[k].w), bfhi(mv[k].w)}; }
                    u32x4 w; w.x = cvt_pk_bf16(v0[0], v0[1]); w.y = cvt_pk_bf16(v0[2], v0[3]); w.z = cvt_pk_bf16(v1[0], v1[1]); w.w = cvt_pk_bf16(v1[2], v1[3]);
                    *(u32x4*)(mo + (size_t)(ai * 128 + m * 16) * MBP + bj * 128) = w; }
                pa += 4 * 512; asm volatile("" : "+v"(pa) :: "memory");
            }
        }
        pg8::zero_acc(acc);
    }
};

struct Ctx { int tid, lane, wave, gw, ngw; LAS unsigned char* lds; };

__device__ __forceinline__ void phase_ada(const Params& p, const Ctx& C) {
    LAS float* sil = (LAS float*)C.lds; LAS float* red = (LAS float*)(C.lds + 69632);
    const float* cv = p.in[1]; const float* cctx = p.in[3];
    for (int i = C.tid; i < 17 * 1024; i += 512) { const float v = (i < 16384) ? cv[i] : cctx[i - 16384]; sil[i] = v / (1.f + __expf(-v)); }
    __syncthreads();
    float* mod = (float*)(p.ws + WS_MOD);
    for (int cb = blockIdx.x; cb < 256; cb += gridDim.x) {
        const int l = cb >> 7, j0 = (cb & 127) * 48;
        const float* W = p.in[4] + (size_t)l * 1024 * 6144;
        const int cl = C.tid % 48, ks = C.tid / 48;
        float a[17];
#pragma unroll
        for (int r = 0; r < 17; ++r) a[r] = 0.f;
        if (ks < 10) {
            int k = ks;
            for (; k + 70 < 1024; k += 80) {
                float w[8];
#pragma unroll
                for (int q = 0; q < 8; ++q) w[q] = W[(size_t)(k + 10 * q) * 6144 + j0 + cl];
#pragma unroll
                for (int r = 0; r < 17; ++r) {
                    float t0 = sil[r * 1024 + k] * w[0] + sil[r * 1024 + k + 10] * w[1], t1 = sil[r * 1024 + k + 20] * w[2] + sil[r * 1024 + k + 30] * w[3];
                    float t2 = sil[r * 1024 + k + 40] * w[4] + sil[r * 1024 + k + 50] * w[5], t3 = sil[r * 1024 + k + 60] * w[6] + sil[r * 1024 + k + 70] * w[7];
                    a[r] += (t0 + t1) + (t2 + t3); }
            }
            for (; k < 1024; k += 10) { const float w = W[(size_t)k * 6144 + j0 + cl];
#pragma unroll
                for (int r = 0; r < 17; ++r) a[r] += sil[r * 1024 + k] * w; }
#pragma unroll
            for (int r = 0; r < 17; ++r) red[(ks * 17 + r) * 48 + cl] = a[r];
        }
        __syncthreads();
        for (int o = C.tid; o < 17 * 48; o += 512) { const int r = o / 48, cc = o % 48; float s = p.in[5][l * 6144 + j0 + cc];
            for (int k2 = 0; k2 < 10; ++k2) s += red[(k2 * 17 + r) * 48 + cc];
            mod[(size_t)(l * 17 + r) * 6144 + j0 + cc] = s; }
        __syncthreads();
    }
}

struct CvtJob { const float* src; int src_ld; bf16_t* dst; int dst_ld; int K; int N; int map; const float* kscale; };
__device__ __forceinline__ int srccol(int map, int n0) {
    if (map == 0) return n0;
    if (map == 1) { if (n0 < 1792) return n0; if (n0 < 2304) return 1824 + (n0 - 1792); if (n0 < 2688) return 2336 + (n0 - 2304); if (n0 < 2944) return 2720 + (n0 - 2688);
        if (n0 == 2944) return 2976; if (n0 == 2976) return 1792; return -1; }
    if (map == 2) { if (n0 < 512) return (n0 >> 6) * 96 + (n0 & 63); const int m = n0 - 512; return (m >> 5) * 96 + 64; }
    { if (n0 < 512) return (n0 >> 6) * 128 + (n0 & 63); const int m = n0 - 512; return (m >> 6) * 128 + 64 + (m & 63); }
}
__device__ __forceinline__ void cvt_item(const CvtJob& J, int item, LAS float* scr, int lane) {
    const int nblk = J.N / 32, kb = item / nblk, nb = item % nblk, k0 = 64 * kb, n0 = 32 * nb;
    const int sc = srccol(J.map, n0);
#pragma unroll
    for (int i = 0; i < 8; ++i) { const int kk = 8 * i + (lane >> 3), c4 = (lane & 7) * 4; f32x4 v = {0.f, 0.f, 0.f, 0.f};
        if (sc >= 0) { v = *(const f32x4*)(J.src + (size_t)(k0 + kk) * J.src_ld + sc + c4); if (J.kscale) v = v * J.kscale[k0 + kk]; }
        scr[kk * 33 + c4] = v[0]; scr[kk * 33 + c4 + 1] = v[1]; scr[kk * 33 + c4 + 2] = v[2]; scr[kk * 33 + c4 + 3] = v[3]; }
    LDS_WAIT(); asm volatile("" ::: "memory");
    const int c = lane & 7;
#pragma unroll
    for (int j = 0; j < 4; ++j) { const int n = (lane >> 3) + 8 * j; const LAS float* s = scr + (8 * c) * 33 + n;
        u32x4 o; o.x = cvt_pk_bf16(s[0 * 33], s[1 * 33]); o.y = cvt_pk_bf16(s[2 * 33], s[3 * 33]); o.z = cvt_pk_bf16(s[4 * 33], s[5 * 33]); o.w = cvt_pk_bf16(s[6 * 33], s[7 * 33]);
        *(u32x4*)(J.dst + (size_t)(n0 + n) * J.dst_ld + k0 + 8 * c) = o; }
    LDS_WAIT(); asm volatile("" ::: "memory");
}
__device__ __forceinline__ void run_cvt(const CvtJob& J, const Ctx& C) {
    LAS float* scr = (LAS float*)(C.lds + C.wave * 16384);
    const int items = (J.K / 64) * (J.N / 32);
    for (int it = C.gw; it < items; it += C.ngw) cvt_item(J, it, scr, C.lane);
}
__device__ __forceinline__ void convert_group1(const Params& p, int l, const Ctx& C) {
    unsigned char* ws = p.ws;
    { CvtJob J{p.in[10] + (size_t)l * D * DIN, DIN, (bf16_t*)(ws + WS_WIN), 1024, 1024, 3072, 1, nullptr}; run_cvt(J, C); }
    { CvtJob J{p.in[18] + (size_t)l * 384 * 768, 768, (bf16_t*)(ws + WS_WUQ), 384, 384, 768, 2, p.in[16] + l * 384}; run_cvt(J, C); }
    { CvtJob J{p.in[19] + (size_t)l * 256 * 1024, 1024, (bf16_t*)(ws + WS_WUKV), 384, 256, 1024, 3, p.in[17] + l * 256}; run_cvt(J, C); }
    for (int z = 0; z < 3; ++z) {
        { CvtJob J{p.in[10] + (size_t)l * D * DIN + 3008 + z * 1024, DIN, (bf16_t*)(ws + WS_WMG) + (size_t)z * 1024 * 1536, 1536, 1024, 1024, 0, nullptr}; run_cvt(J, C); }
        { CvtJob J{p.in[20] + ((size_t)l * 3 + z) * 512 * 1024, 1024, (bf16_t*)(ws + WS_WMG) + (size_t)z * 1024 * 1536 + 1024, 1536, 512, 1024, 0, nullptr}; run_cvt(J, C); }
    }
    { CvtJob J{p.in[21] + (size_t)l * D * D, 1024, (bf16_t*)(ws + WS_WOUT), 1024, 1024, 1024, 0, nullptr}; run_cvt(J, C); }
}
__device__ __forceinline__ void convert_group2(const Params& p, int l, const Ctx& C) {
    unsigned char* ws = p.ws;
    { CvtJob J{p.in[22] + (size_t)l * D * DFF, DFF, (bf16_t*)(ws + WS_WM1), 1024, 1024, 4096, 0, nullptr}; run_cvt(J, C); }
    { CvtJob J{p.in[23] + (size_t)l * DFF * D, 1024, (bf16_t*)(ws + WS_WM2), 4096, 4096, 1024, 0, nullptr}; run_cvt(J, C); }
}

struct RowArgs {
    const float* x_lat; const float* x_ctx; float* xo_lat; float* xo_ctx;
    const bf16_t* delta; const float* dstats; const float* gpost; const float* modg; int gate_idx;
    const float* gpre; const float* modh; int sh_idx, sc_idx; bf16_t* hout; int skip_ctx;
};
__device__ __forceinline__ void phase_rows(const RowArgs& a, const Ctx& C) {
    const int lane = C.lane;
    const int total = a.skip_ctx ? NB * NLAT : R;
    const int rpw = (total + C.ngw - 1) / C.ngw;
    const int i0 = C.gw * rpw, i1 = (i0 + rpw < total) ? i0 + rpw : total;
    int cur = -1;
    f32x4 vgate[4], vgpost[4], vgpre[4], vsh[4], vsc[4];
#pragma unroll
    for (int q = 0; q < 4; ++q) { vgate[q] = vgpost[q] = vgpre[q] = vsh[q] = vsc[q] = (f32x4){0.f, 0.f, 0.f, 0.f}; }
    if (a.delta) {
#pragma unroll
        for (int q = 0; q < 4; ++q) vgpost[q] = *(const f32x4*)(a.gpost + 4 * lane + 256 * q);
    }
    if (a.hout) {
#pragma unroll
        for (int q = 0; q < 4; ++q) vgpre[q] = *(const f32x4*)(a.gpre + 4 * lane + 256 * q);
    }
    for (int i = i0; i < i1; ++i) {
        int b, j;
        if (a.skip_ctx) { b = i >> 11; j = NCTX + (i & (NLAT - 1)); } else { b = i / RB; j = i - b * RB; }
        const int r = b * RB + j; const bool isctx = j < NCTX;
        const size_t xoff = isctx ? (size_t)(b * NCTX + j) * D : (size_t)(b * NLAT + (j - NCTX)) * D;
        const float* xin = (isctx ? a.x_ctx : a.x_lat) + xoff;
        const int mrow = isctx ? 16 : b;
        f32x4 x[4];
#pragma unroll
        for (int q = 0; q < 4; ++q) x[q] = *(const f32x4*)(xin + 4 * lane + 256 * q);
        u32x2 yv[4]; float ss = 0.f;
        if (a.delta) {
#pragma unroll
            for (int q = 0; q < 4; ++q) yv[q] = *(const u32x2*)(a.delta + (size_t)r * HBP + 4 * lane + 256 * q);
            ss = (lane < 32) ? a.dstats[(size_t)r * 32 + lane] : 0.f;
        }
        if (mrow != cur) {
            cur = mrow;
            if (a.delta) { const float* gt = a.modg + (size_t)mrow * 6144 + a.gate_idx * 1024;
#pragma unroll
                for (int q = 0; q < 4; ++q) vgate[q] = *(const f32x4*)(gt + 4 * lane + 256 * q); }
            if (a.hout) { const float* sh = a.modh + (size_t)mrow * 6144 + a.sh_idx * 1024; const float* sc = a.modh + (size_t)mrow * 6144 + a.sc_idx * 1024;
#pragma unroll
                for (int q = 0; q < 4; ++q) { vsh[q] = *(const f32x4*)(sh + 4 * lane + 256 * q); vsc[q] = *(const f32x4*)(sc + 4 * lane + 256 * q) + 1.f; } }
        }
        if (a.delta) {
            ss = wave_sum(ss);
            const float rs = rsqrtf(ss * (1.f / 1024.f) + EPS);
#pragma unroll
            for (int q = 0; q < 4; ++q) {
                x[q][0] += vgate[q][0] * (bflo(yv[q].x) * rs * vgpost[q][0]); x[q][1] += vgate[q][1] * (bfhi(yv[q].x) * rs * vgpost[q][1]);
                x[q][2] += vgate[q][2] * (bflo(yv[q].y) * rs * vgpost[q][2]); x[q][3] += vgate[q][3] * (bfhi(yv[q].y) * rs * vgpost[q][3]); }
        }
        float* xo = isctx ? a.xo_ctx : a.xo_lat;
        if (xo) {
#pragma unroll
            for (int q = 0; q < 4; ++q) *(f32x4*)(xo + xoff + 4 * lane + 256 * q) = x[q];
        }
        if (a.hout) {
            float s2 = 0.f;
#pragma unroll
            for (int q = 0; q < 4; ++q) s2 += (x[q][0] * x[q][0] + x[q][1] * x[q][1]) + (x[q][2] * x[q][2] + x[q][3] * x[q][3]);
            s2 = wave_sum(s2); const float rs = rsqrtf(s2 * (1.f / 1024.f) + EPS);
#pragma unroll
            for (int q = 0; q < 4; ++q) {
                const float h0 = (x[q][0] * rs * vgpre[q][0]) * vsc[q][0] + vsh[q][0], h1 = (x[q][1] * rs * vgpre[q][1]) * vsc[q][1] + vsh[q][1];
                const float h2 = (x[q][2] * rs * vgpre[q][2]) * vsc[q][2] + vsh[q][2], h3 = (x[q][3] * rs * vgpre[q][3]) * vsc[q][3] + vsh[q][3];
                u32x2 w; w.x = cvt_pk_bf16(h0, h1); w.y = cvt_pk_bf16(h2, h3);
                *(u32x2*)(a.hout + (size_t)r * HBP + 4 * lane + 256 * q) = w; }
        }
    }
}

__device__ __forceinline__ void phase_prep(const Params& p, int l, const Ctx& C) {
    const int lane = C.lane;
    bf16_t* za = (bf16_t*)(p.ws + WS_ZA); bf16_t* mb = (bf16_t*)(p.ws + WS_MB); const float* stats = (const float*)(p.ws + WS_STATS);
    const float* gq = p.in[11] + l * 64; const float* gk = p.in[12] + l * 64;
    const float qs = 0.125f * LOG2E;
    constexpr int NR = 4;
    for (int r0 = C.gw; r0 < R; r0 += NR * C.ngw) {
        unsigned v[NR][5]; float ssum[NR][5]; unsigned kr[NR];
#pragma unroll
        for (int q = 0; q < NR; ++q) { const int r = r0 + q * C.ngw;
            if (r < R) {
#pragma unroll
                for (int it = 0; it < 5; ++it) { const int col = 2 * (lane + 64 * it), head = col >> 6;
                    v[q][it] = *(const unsigned*)(za + (size_t)r * ZAP + col);
                    ssum[q][it] = stats[(size_t)r * 40 + 2 * head] + stats[(size_t)r * 40 + 2 * head + 1]; }
                kr[q] = (lane < 16) ? *(const unsigned*)(mb + (size_t)r * MBP + 1792 + 2 * lane) : 0u;
            }
        }
#pragma unroll
        for (int q = 0; q < NR; ++q) { const int r = r0 + q * C.ngw;
            if (r < R) {
                int b, j; row_info(r, b, j); const bool lat = j >= NCTX; const int tkn = j - NCTX; const float grow = (float)(tkn >> 6), gcol = (float)(tkn & 63);
#pragma unroll
                for (int it = 0; it < 5; ++it) {
                    const int col = 2 * (lane + 64 * it), head = col >> 6, i = (col & 63) >> 1;
                    const float rs = rsqrtf(ssum[q][it] * (1.f / 64.f) + EPS);
                    const float* g = head < 8 ? gq : gk;
                    float x0 = bflo(v[q][it]) * rs * g[2 * i], x1 = bfhi(v[q][it]) * rs * g[2 * i + 1];
                    if (lat) { const float pos = (i < 16) ? grow : gcol; const int f = i & 15;
                        float rev = pos * exp2f(-(float)f * (L2THETA / 16.f)) * 0.15915494309189535f; rev -= rintf(rev);
                        const float sn = __builtin_amdgcn_sinf(rev), cs = __builtin_amdgcn_cosf(rev);
                        const float y0 = x0 * cs - x1 * sn, y1 = x0 * sn + x1 * cs; x0 = y0; x1 = y1; }
                    if (head < 8) { x0 *= qs; x1 *= qs; }
                    *(unsigned*)(za + (size_t)r * ZAP + col) = cvt_pk_bf16(x0, x1);
                }
                if (lat && lane < 16) { const int i = lane;
                    const float x0 = bflo(kr[q]), x1 = bfhi(kr[q]); const float pos = (i < 8) ? grow : gcol; const int f = i & 7;
                    float rev = pos * exp2f(-(float)f * (L2THETA / 8.f)) * 0.15915494309189535f; rev -= rintf(rev);
                    const float sn = __builtin_amdgcn_sinf(rev), cs = __builtin_amdgcn_cosf(rev);
                    *(unsigned*)(mb + (size_t)r * MBP + 1792 + 2 * i) = cvt_pk_bf16(x0 * cs - x1 * sn, x0 * sn + x1 * cs); }
            }
        }
    }
}

__device__ __forceinline__ float xmax4(float m) {
    { auto r = __builtin_amdgcn_permlane16_swap(__float_as_uint(m), __float_as_uint(m), false, false); m = __builtin_fmaxf(__uint_as_float(r[0]), __uint_as_float(r[1])); }
    { auto r = __builtin_amdgcn_permlane32_swap(__float_as_uint(m), __float_as_uint(m), false, false); m = __builtin_fmaxf(__uint_as_float(r[0]), __uint_as_float(r[1])); }
    return m;
}
__device__ __forceinline__ float xsum4(float m) {
    { auto r = __builtin_amdgcn_permlane16_swap(__float_as_uint(m), __float_as_uint(m), false, false); m = __uint_as_float(r[0]) + __uint_as_float(r[1]); }
    { auto r = __builtin_amdgcn_permlane32_swap(__float_as_uint(m), __float_as_uint(m), false, false); m = __uint_as_float(r[0]) + __uint_as_float(r[1]); }
    return m;
}
template <bool DO_MAX>
__device__ __forceinline__ void attn_softmax(f32x4 (&s)[4], f32x4& lsum, float& dpend, bf16x8 (&pf)[2]) {
    if (DO_MAX) {
    float mx = max3f(s[0][0], s[0][1], s[0][2]); float mx2 = max3f(s[0][3], s[1][0], s[1][1]);
    mx = max3f(mx, s[1][2], s[1][3]); mx2 = max3f(mx2, s[2][0], s[2][1]);
    mx = max3f(mx, s[2][2], s[2][3]); mx2 = max3f(mx2, s[3][0], s[3][1]);
    mx = max3f(mx, s[3][2], s[3][3]); dpend = xmax4(__builtin_fmaxf(mx, mx2));
    } else { dpend = -1e30f; }
#pragma unroll
    for (int kt = 0; kt < 4; ++kt) {
#pragma unroll
        for (int e = 0; e < 4; ++e) s[kt][e] = __builtin_amdgcn_exp2f(s[kt][e]);
        lsum += s[kt]; }
#pragma unroll
    for (int kb2 = 0; kb2 < 2; ++kb2) {
        u32x4 w; w.x = cvt_pk_bf16(s[2 * kb2][0], s[2 * kb2][1]); w.y = cvt_pk_bf16(s[2 * kb2][2], s[2 * kb2][3]);
        w.z = cvt_pk_bf16(s[2 * kb2 + 1][0], s[2 * kb2 + 1][1]); w.w = cvt_pk_bf16(s[2 * kb2 + 1][2], s[2 * kb2 + 1][3]);
        pf[kb2] = __builtin_bit_cast(bf16x8, w);
    }
}

constexpr float ATT_THR = 10.f;
template <int NDS, bool DO_MAX>
__device__ __forceinline__ void attn_core(const LAS unsigned char* Kc, const LAS unsigned char* Vc, const bf16x8 (&qf)[2][NDS], f32x4 (&oacc)[2][4], const f32x4& c0, const f32x4& c1, f32x4 (&lsum)[2], float (&dnew)[2], int fr, int g) {
    constexpr int KP = NDS * 64 + 32, VP = 144;
    bf16x8 kf[4][NDS];
#pragma unroll
    for (int kt = 0; kt < 4; ++kt)
#pragma unroll
        for (int ds = 0; ds < NDS; ++ds) kf[kt][ds] = *(const LAS bf16x8*)(Kc + (kt * 16 + fr) * KP + ds * 64 + g * 16);
    f32x4 s0[4], s1[4];
#pragma unroll
    for (int kt = 0; kt < 4; ++kt)
#pragma unroll
        for (int ds = 0; ds < NDS; ++ds) s0[kt] = __builtin_amdgcn_mfma_f32_16x16x32_bf16(kf[kt][ds], qf[0][ds], ds == 0 ? c0 : s0[kt], 0, 0, 0);
#pragma unroll
    for (int kt = 0; kt < 4; ++kt)
#pragma unroll
        for (int ds = 0; ds < NDS; ++ds) s1[kt] = __builtin_amdgcn_mfma_f32_16x16x32_bf16(kf[kt][ds], qf[1][ds], ds == 0 ? c1 : s1[kt], 0, 0, 0);
    bf16x8 pf0[2], pf1[2];
    attn_softmax<DO_MAX>(s0, lsum[0], dnew[0], pf0);
    attn_softmax<DO_MAX>(s1, lsum[1], dnew[1], pf1);
#pragma unroll
    for (int kb2 = 0; kb2 < 2; ++kb2)
#pragma unroll
        for (int dvt = 0; dvt < 4; ++dvt) {
            const LAS unsigned char* va = Vc + (kb2 * 32 + 4 * g + (fr >> 2)) * VP + (dvt * 16 + 4 * (fr & 3)) * 2;
            const s16x4 lo = __builtin_bit_cast(s16x4, __builtin_amdgcn_ds_read_tr16_b64_v4i16((LAS s16x4*)va));
            const s16x4 hi = __builtin_bit_cast(s16x4, __builtin_amdgcn_ds_read_tr16_b64_v4i16((LAS s16x4*)(va + 16 * VP)));
            const bf16x8 vf = (bf16x8){lo[0], lo[1], lo[2], lo[3], hi[0], hi[1], hi[2], hi[3]};
            oacc[0][dvt] = __builtin_amdgcn_mfma_f32_16x16x32_bf16(vf, pf0[kb2], oacc[0][dvt], 0, 0, 0);
            oacc[1][dvt] = __builtin_amdgcn_mfma_f32_16x16x32_bf16(vf, pf1[kb2], oacc[1][dvt], 0, 0, 0);
        }
}

template <int NDS>
__device__ __forceinline__ void attn_unit(LAS unsigned char* lds, const bf16_t* q1, const bf16_t* q2, int qpitch, const bf16_t* k1, const bf16_t* k2, int kpitch,
                                          const bf16_t* v, int vpitch, bf16_t* o, int opitch, int nkeys) {
    constexpr int KP = NDS * 64 + 32, VP = 144, KBUF = 64 * KP, VBUF = 64 * VP;
    int tid_ = threadIdx.x; asm volatile("" : "+v"(tid_));
    const int tid = tid_, lane = tid & 63, wid = tid >> 6, fr = lane & 15, g = lane >> 4;
    LAS unsigned char* Kb = lds; LAS unsigned char* Vb = lds + 4 * KBUF;
    bf16x8 qf[2][NDS];
#pragma unroll
    for (int qt = 0; qt < 2; ++qt) { const size_t ro = (size_t)(wid * 32 + qt * 16 + fr) * qpitch;
#pragma unroll
        for (int ds = 0; ds < NDS; ++ds) qf[qt][ds] = (ds < 2) ? *(const bf16x8*)(q1 + ro + ds * 32 + g * 8) : *(const bf16x8*)(q2 + ro + g * 8); }
    f32x4 oacc[2][4];
    float mrun[2], dpend[2]; f32x4 lsum[2];
#pragma unroll
    for (int qt = 0; qt < 2; ++qt) { mrun[qt] = 0.f; lsum[qt] = (f32x4){0.f, 0.f, 0.f, 0.f}; dpend[qt] = 0.f;
#pragma unroll
        for (int d = 0; d < 4; ++d) oacc[qt][d] = (f32x4){0.f, 0.f, 0.f, 0.f}; }
    const int NT = nkeys / 64;
    const int skey = tid >> 3, sch = tid & 7, skey2 = tid >> 2, sch2 = tid & 3;
    const bool two = (NDS == 3) && tid < 256;
    u32x4 ak, ak2, av, bk, bk2, bv;
#define ATT_LOAD(rk_, rk2_, rv_, t_) do { const size_t kr_ = (size_t)(t_) * 64; \
        rk_ = *(const u32x4*)(k1 + (kr_ + skey) * kpitch + sch * 8); rv_ = *(const u32x4*)(v + (kr_ + skey) * vpitch + sch * 8); \
        if (two) rk2_ = *(const u32x4*)(k2 + (kr_ + skey2) * kpitch + sch2 * 8); } while (0)
#define ATT_STORE(rk_, rk2_, rv_, nb_) do { *(LAS u32x4*)(Kb + (nb_) * KBUF + skey * KP + sch * 16) = rk_; *(LAS u32x4*)(Vb + (nb_) * VBUF + skey * VP + sch * 16) = rv_; \
        if (two) *(LAS u32x4*)(Kb + (nb_) * KBUF + skey2 * KP + 128 + sch2 * 16) = rk2_; } while (0)
    ATT_LOAD(ak, ak2, av, 0); ATT_LOAD(bk, bk2, bv, 1);
    ATT_STORE(ak, ak2, av, 0); ATT_STORE(bk, bk2, bv, 1);
    __syncthreads();
    for (int t = 0; t < NT; t += 2) {
        const int pb = (t >> 1) & 1, nb = pb ^ 1;
        const bool more = t + 2 < NT;
        if (more) { ATT_LOAD(ak, ak2, av, t + 2); ATT_LOAD(bk, bk2, bv, t + 3); }
#pragma unroll
        for (int qt = 0; qt < 2; ++qt) {
            if (__any(dpend[qt] > ATT_THR)) {
                const float d = __builtin_fmaxf(dpend[qt], 0.f), alpha = __builtin_amdgcn_exp2f(-d);
                mrun[qt] += d; lsum[qt] *= alpha;
#pragma unroll
                for (int dv = 0; dv < 4; ++dv) oacc[qt][dv] *= alpha;
            }
        }
        float da[2], db[2];
        const f32x4 c0 = {-mrun[0], -mrun[0], -mrun[0], -mrun[0]}, c1 = {-mrun[1], -mrun[1], -mrun[1], -mrun[1]};
        attn_core<NDS, true>(Kb + (2 * pb) * KBUF, Vb + (2 * pb) * VBUF, qf, oacc, c0, c1, lsum, da, fr, g);
        attn_core<NDS, false>(Kb + (2 * pb + 1) * KBUF, Vb + (2 * pb + 1) * VBUF, qf, oacc, c0, c1, lsum, db, fr, g);
        dpend[0] = __builtin_fmaxf(da[0], db[0]); dpend[1] = __builtin_fmaxf(da[1], db[1]);
        if (more) { ATT_STORE(ak, ak2, av, 2 * nb); ATT_STORE(bk, bk2, bv, 2 * nb + 1); }
        __syncthreads();
    }
#undef ATT_LOAD
#undef ATT_STORE
    { LAS unsigned char* stg = lds + wid * 4608;
#pragma unroll
      for (int qt = 0; qt < 2; ++qt) {
        const float inv = 1.f / xsum4((lsum[qt][0] + lsum[qt][1]) + (lsum[qt][2] + lsum[qt][3]));
#pragma unroll
        for (int dvt = 0; dvt < 4; ++dvt) { u32x2 w; w.x = cvt_pk_bf16(oacc[qt][dvt][0] * inv, oacc[qt][dvt][1] * inv); w.y = cvt_pk_bf16(oacc[qt][dvt][2] * inv, oacc[qt][dvt][3] * inv);
            *(LAS u32x2*)(stg + (qt * 16 + fr) * 144 + (dvt * 16 + 4 * g) * 2) = w; }
      }
      LDS_WAIT(); asm volatile("" ::: "memory");
#pragma unroll
      for (int j = 0; j < 4; ++j) { const int c = j * 64 + lane, row = c >> 3, ch = c & 7;
          const u32x4 v4 = *(const LAS u32x4*)(stg + row * 144 + ch * 16);
          *(u32x4*)(o + (size_t)(wid * 32 + row) * opitch + ch * 8) = v4; }
      LDS_WAIT(); asm volatile("" ::: "memory");
    }
}

#define GLA_LBAR() asm volatile("s_waitcnt lgkmcnt(0)\n\ts_barrier" ::: "memory")
__device__ __forceinline__ void gla_unit(const Params& p, int l, int b, int h, LAS unsigned char* lds) {
    constexpr int P144 = 144, VVP = 272, HALFB = 68864;
    int tid_ = threadIdx.x; asm volatile("" : "+v"(tid_));
    const int tid = tid_, lane = tid & 63, wid = tid >> 6, fr = lane & 15, g = lane >> 4;
    const int dir = wid >> 2, w4 = wid & 3, ht = tid & 255;
    LAS unsigned char* base = lds + dir * HALFB;
    LAS unsigned char* QD = base;
    LAS unsigned char* KD = base + 9216;
    LAS unsigned char* KE = base + 18432;
    LAS unsigned char* VV = base + 27648;
    LAS unsigned char* ST = base + 45056;
    LAS float* LRs = (LAS float*)(base + 63488);
    LAS float* SEG = (LAS float*)(base + 67584);
    LAS float* GV = (LAS float*)(base + 68608);
    const bf16_t* zb = (const bf16_t*)(p.ws + WS_ZB); const float* lrg = (const float*)(p.ws + WS_LR);
    bf16_t* ob = (bf16_t*)(p.ws + WS_HB) + 1536 + h * 128;
    const float* gout = p.in[15] + l * 128;
    const int d = ht & 63, seg = ht >> 6;
    const int lt = ht >> 2, lc = ht & 3;
    float wa[16];
#pragma unroll
    for (int r2 = 0; r2 < 16; ++r2) wa[r2] = p.in[13][(((size_t)l * 2 + dir) * 16 + r2) * 256 + h * 64 + d];
    const float ba = p.in[14][((size_t)l * 2 + dir) * 256 + h * 64 + d];
    f32x4 sreg[8];
#pragma unroll
    for (int i = 0; i < 8; ++i) sreg[i] = (f32x4){0.f, 0.f, 0.f, 0.f};
    u32x4 pq[2], pk[2], pv[4]; f32x4 plr;
#define GLA_ROW(cc_, t_) ((size_t)b * RB + ((cc_) < 4 ? 0 : NCTX) + (size_t)(dir == 0 ? (((cc_) < 4 ? (cc_) : (cc_) - 4) * 64 + (t_)) : (((cc_) < 4 ? NCTX : NLAT) - 1 - (((cc_) < 4 ? (cc_) : (cc_) - 4) * 64 + (t_)))))
#define GLA_ISSUE(cc_) do { const bf16_t* rp_ = zb + GLA_ROW(cc_, lt) * ZBP; \
        pq[0] = *(const u32x4*)(rp_ + h * 64 + lc * 16); pq[1] = *(const u32x4*)(rp_ + h * 64 + lc * 16 + 8); \
        pk[0] = *(const u32x4*)(rp_ + 256 + h * 64 + lc * 16); pk[1] = *(const u32x4*)(rp_ + 256 + h * 64 + lc * 16 + 8); \
        pv[0] = *(const u32x4*)(rp_ + 512 + h * 128 + lc * 32); pv[1] = *(const u32x4*)(rp_ + 512 + h * 128 + lc * 32 + 8); \
        pv[2] = *(const u32x4*)(rp_ + 512 + h * 128 + lc * 32 + 16); pv[3] = *(const u32x4*)(rp_ + 512 + h * 128 + lc * 32 + 24); \
        plr = *(const f32x4*)(lrg + GLA_ROW(cc_, lt) * 32 + dir * 16 + lc * 4); } while (0)
    GLA_ISSUE(0);
    for (int cc = 0; cc < 36; ++cc) {
#pragma unroll
        for (int vvt = 0; vvt < 8; ++vvt) { u32x2 w; w.x = cvt_pk_bf16(sreg[vvt][0], sreg[vvt][1]); w.y = cvt_pk_bf16(sreg[vvt][2], sreg[vvt][3]);
            *(LAS u32x2*)(ST + (vvt * 16 + fr) * P144 + (w4 * 16 + 4 * g) * 2) = w; }
        *(LAS u32x4*)(QD + lt * P144 + lc * 32) = pq[0]; *(LAS u32x4*)(QD + lt * P144 + lc * 32 + 16) = pq[1];
        *(LAS u32x4*)(KD + lt * P144 + lc * 32) = pk[0]; *(LAS u32x4*)(KD + lt * P144 + lc * 32 + 16) = pk[1];
#pragma unroll
        for (int i = 0; i < 4; ++i) *(LAS u32x4*)(VV + lt * VVP + lc * 64 + i * 16) = pv[i];
        *(LAS f32x4*)(LRs + lt * 16 + lc * 4) = plr;
        if (cc + 1 < 36) GLA_ISSUE(cc + 1);
        GLA_LBAR();
        float cb[16]; float run = 0.f;
#pragma unroll
        for (int e = 0; e < 16; ++e) { const LAS f32x4* lp = (const LAS f32x4*)(LRs + (seg * 16 + e) * 16); float lg = ba;
#pragma unroll
            for (int r4 = 0; r4 < 4; ++r4) { const f32x4 lv = lp[r4]; lg += (lv[0] * wa[4 * r4] + lv[1] * wa[4 * r4 + 1]) + (lv[2] * wa[4 * r4 + 2] + lv[3] * wa[4 * r4 + 3]); }
            const float ls = fminf(lg, 0.f) - __logf(1.f + __expf(-fabsf(lg)));
            run += ls * (1.f / 16.f); cb[e] = run; }
        SEG[seg * 64 + d] = run;
        GLA_LBAR();
        float pre = 0.f, tot = 0.f;
#pragma unroll
        for (int s2 = 0; s2 < 4; ++s2) { const float v2 = SEG[s2 * 64 + d]; tot += v2; if (s2 < seg) pre += v2; }
        float ke[16];
#pragma unroll
        for (int e = 0; e < 16; ++e) { const float bb = pre + cb[e]; const int t = seg * 16 + e;
            LAS unsigned short* qp = (LAS unsigned short*)(QD + t * P144 + d * 2); LAS unsigned short* kp = (LAS unsigned short*)(KD + t * P144 + d * 2);
            const float qv = bf2f(*qp), kv = bf2f(*kp);
            const float qd = qv * 0.125f * __expf(bb), kd = kv * __expf(-bb); ke[e] = kv * __expf(tot - bb);
            *qp = (unsigned short)(cvt_pk_bf16(qd, 0.f) & 0xffffu); *kp = (unsigned short)(cvt_pk_bf16(kd, 0.f) & 0xffffu); }
        { u32x4 w; w.x = cvt_pk_bf16(ke[0], ke[1]); w.y = cvt_pk_bf16(ke[2], ke[3]); w.z = cvt_pk_bf16(ke[4], ke[5]); w.w = cvt_pk_bf16(ke[6], ke[7]);
          *(LAS u32x4*)(KE + d * P144 + seg * 32) = w;
          w.x = cvt_pk_bf16(ke[8], ke[9]); w.y = cvt_pk_bf16(ke[10], ke[11]); w.z = cvt_pk_bf16(ke[12], ke[13]); w.w = cvt_pk_bf16(ke[14], ke[15]);
          *(LAS u32x4*)(KE + d * P144 + seg * 32 + 16) = w; }
        if (seg == 0) GV[d] = __expf(tot);
        GLA_LBAR();
        const int it = w4;
        bf16x8 qfr[2];
#pragma unroll
        for (int ds = 0; ds < 2; ++ds) qfr[ds] = *(const LAS bf16x8*)(QD + (it * 16 + fr) * P144 + ds * 64 + g * 16);
        f32x4 T[4];
#pragma unroll
        for (int jt = 0; jt < 4; ++jt) {
            T[jt] = (f32x4){0.f, 0.f, 0.f, 0.f};
            if (jt <= it) {
#pragma unroll
                for (int ds = 0; ds < 2; ++ds) { const bf16x8 kf = *(const LAS bf16x8*)(KD + (jt * 16 + fr) * P144 + ds * 64 + g * 16);
                    T[jt] = __builtin_amdgcn_mfma_f32_16x16x32_bf16(kf, qfr[ds], T[jt], 0, 0, 0); }
                if (jt == it) {
#pragma unroll
                    for (int e = 0; e < 4; ++e) if (4 * g + e > fr) T[jt][e] = 0.f;
                }
            }
        }
        bf16x8 pfr[2];
#pragma unroll
        for (int jb = 0; jb < 2; ++jb) { u32x4 w; w.x = cvt_pk_bf16(T[2 * jb][0], T[2 * jb][1]); w.y = cvt_pk_bf16(T[2 * jb][2], T[2 * jb][3]);
            w.z = cvt_pk_bf16(T[2 * jb + 1][0], T[2 * jb + 1][1]); w.w = cvt_pk_bf16(T[2 * jb + 1][2], T[2 * jb + 1][3]); pfr[jb] = __builtin_bit_cast(bf16x8, w); }
        const int cin = cc < 4 ? cc : cc - 4; const int other = cc < 4 ? 3 - cin : 35 - cin; const bool second = cc > other;
        const size_t orow = GLA_ROW(cc, it * 16 + fr);
        unsigned long long part[8]; u32x2 gts[8];
        if (second) {
#pragma unroll
            for (int vvt = 0; vvt < 8; ++vvt) { part[vvt] = __hip_atomic_load((const unsigned long long*)(ob + orow * HBP + vvt * 16 + 4 * g), __ATOMIC_RELAXED, __HIP_MEMORY_SCOPE_AGENT);
                gts[vvt] = *(const u32x2*)(zb + orow * ZBP + 1024 + h * 128 + vvt * 16 + 4 * g); }
        }
        f32x4 oacc[8];
        const f32x4 gd = *(const LAS f32x4*)(GV + it * 16 + 4 * g);
#pragma unroll
        for (int vvt = 0; vvt < 8; ++vvt) {
            oacc[vvt] = (f32x4){0.f, 0.f, 0.f, 0.f};
#pragma unroll
            for (int jb = 0; jb < 2; ++jb) {
                if (2 * jb <= it) {
                    const LAS unsigned char* va = VV + (jb * 32 + 4 * g + (fr >> 2)) * VVP + (vvt * 16 + 4 * (fr & 3)) * 2;
                    const s16x4 lo = __builtin_bit_cast(s16x4, __builtin_amdgcn_ds_read_tr16_b64_v4i16((LAS s16x4*)va));
                    const s16x4 hi = __builtin_bit_cast(s16x4, __builtin_amdgcn_ds_read_tr16_b64_v4i16((LAS s16x4*)(va + 16 * VVP)));
                    const bf16x8 vf = (bf16x8){lo[0], lo[1], lo[2], lo[3], hi[0], hi[1], hi[2], hi[3]};
                    oacc[vvt] = __builtin_amdgcn_mfma_f32_16x16x32_bf16(vf, pfr[jb], oacc[vvt], 0, 0, 0);
                }
            }
#pragma unroll
            for (int ds = 0; ds < 2; ++ds) { const bf16x8 sf = *(const LAS bf16x8*)(ST + (vvt * 16 + fr) * P144 + ds * 64 + g * 16);
                oacc[vvt] = __builtin_amdgcn_mfma_f32_16x16x32_bf16(sf, qfr[ds], oacc[vvt], 0, 0, 0); }
            sreg[vvt] = sreg[vvt] * gd;
#pragma unroll
            for (int jb = 0; jb < 2; ++jb) {
                const bf16x8 kef = *(const LAS bf16x8*)(KE + (it * 16 + fr) * P144 + (jb * 32 + 8 * g) * 2);
                const LAS unsigned char* va = VV + (jb * 32 + 8 * g + (fr >> 2)) * VVP + (vvt * 16 + 4 * (fr & 3)) * 2;
                const s16x4 lo = __builtin_bit_cast(s16x4, __builtin_amdgcn_ds_read_tr16_b64_v4i16((LAS s16x4*)va));
                const s16x4 hi = __builtin_bit_cast(s16x4, __builtin_amdgcn_ds_read_tr16_b64_v4i16((LAS s16x4*)(va + 4 * VVP)));
                const bf16x8 vf = (bf16x8){lo[0], lo[1], lo[2], lo[3], hi[0], hi[1], hi[2], hi[3]};
                sreg[vvt] = __builtin_amdgcn_mfma_f32_16x16x32_bf16(kef, vf, sreg[vvt], 0, 0, 0);
            }
        }
        if (!second) {
#pragma unroll
            for (int vvt = 0; vvt < 8; ++vvt) { u32x2 w; w.x = cvt_pk_bf16(oacc[vvt][0], oacc[vvt][1]); w.y = cvt_pk_bf16(oacc[vvt][2], oacc[vvt][3]);
                *(u32x2*)(ob + orow * HBP + vvt * 16 + 4 * g) = w; }
        } else {
            float sq = 0.f;
#pragma unroll
            for (int vvt = 0; vvt < 8; ++vvt) { const unsigned long long pv2 = part[vvt];
                oacc[vvt][0] += bflo((unsigned)pv2); oacc[vvt][1] += bfhi((unsigned)pv2); oacc[vvt][2] += bflo((unsigned)(pv2 >> 32)); oacc[vvt][3] += bfhi((unsigned)(pv2 >> 32));
                sq += (oacc[vvt][0] * oacc[vvt][0] + oacc[vvt][1] * oacc[vvt][1]) + (oacc[vvt][2] * oacc[vvt][2] + oacc[vvt][3] * oacc[vvt][3]); }
            sq += __shfl_xor(sq, 16); sq += __shfl_xor(sq, 32);
            const float rs = rsqrtf(sq * (1.f / 128.f) + EPS);
#pragma unroll
            for (int vvt = 0; vvt < 8; ++vvt) { const int vv = vvt * 16 + 4 * g; const f32x4 go = *(const f32x4*)(gout + vv);
                const float g0 = bflo(gts[vvt].x), g1 = bfhi(gts[vvt].x), g2 = bflo(gts[vvt].y), g3 = bfhi(gts[vvt].y);
                const float r0 = oacc[vvt][0] * rs * go[0] * (g0 * __builtin_amdgcn_rcpf(1.f + __expf(-g0))), r1 = oacc[vvt][1] * rs * go[1] * (g1 * __builtin_amdgcn_rcpf(1.f + __expf(-g1)));
                const float r2 = oacc[vvt][2] * rs * go[2] * (g2 * __builtin_amdgcn_rcpf(1.f + __expf(-g2))), r3 = oacc[vvt][3] * rs * go[3] * (g3 * __builtin_amdgcn_rcpf(1.f + __expf(-g3)));
                u32x2 w; w.x = cvt_pk_bf16(r0, r1); w.y = cvt_pk_bf16(r2, r3);
                *(u32x2*)(ob + orow * HBP + vv) = w; }
        }
        asm volatile("s_waitcnt vmcnt(0) lgkmcnt(0)\n\ts_barrier" ::: "memory");
    }
#undef GLA_ROW
#undef GLA_ISSUE
}

__device__ __forceinline__ void phase_mix(const Params& p, int l, const Ctx& C, unsigned* counter, int which = 7) {
    LAS unsigned* bc = (LAS unsigned*)(C.lds + 147392);
    const int nctx = (l == 0) ? 128 : 0, per = 1024 + nctx, total = 64 + 2 * per;
    bf16_t* za = (bf16_t*)(p.ws + WS_ZA); bf16_t* mb = (bf16_t*)(p.ws + WS_MB); bf16_t* hb = (bf16_t*)(p.ws + WS_HB);
    for (;;) {
        if (C.tid == 0) *bc = atomicAdd(counter, 1u);
        __syncthreads();
        int u = (int)*bc;
        __syncthreads();
        if (u >= total) break;
        if (u < 64) { if (which & 1) gla_unit(p, l, u >> 2, u & 3, C.lds); }
        else {
            u -= 64; int kind, b, head, qt; bool isctx;
            if (u < 2048) { kind = u < 1024 ? 1 : 0; u &= 1023; b = u >> 6; head = (u >> 3) & 7; qt = u & 7; isctx = false; }
            else { u -= 2048; kind = u >= 128; u &= 127; b = u >> 3; head = u & 7; qt = 0; isctx = true; }
            if (!((which >> (1 + kind)) & 1)) continue;
            const size_t q0 = (size_t)b * RB + (isctx ? 0 : NCTX + qt * 256), k0 = (size_t)b * RB; const int nkeys = isctx ? NCTX : RB;
            if (kind == 0) { const int kvh = head >> 2;
                attn_unit<2>(C.lds, za + q0 * ZAP + head * 64, nullptr, ZAP, za + k0 * ZAP + 512 + kvh * 64, nullptr, ZAP, za + k0 * ZAP + 640 + kvh * 64, ZAP, hb + q0 * HBP + 1024 + head * 64, HBP, nkeys); }
            else { attn_unit<3>(C.lds, mb + q0 * MBP + 1024 + head * 64, mb + q0 * MBP + 1536 + head * 32, MBP, mb + k0 * MBP + head * 64, mb + k0 * MBP + 1792, MBP, mb + k0 * MBP + 512 + head * 64, MBP,
                               mb + q0 * MBP + 1024 + head * 64, MBP, nkeys); }
        }
        __syncthreads();
    }
}

constexpr int LDS_BYTES = 147456;
#ifndef PH_MASK
#define PH_MASK 0xFFFF
#endif
#define PH(k) ((PH_MASK >> (k)) & 1)
#ifndef REP_MASK
#define REP_MASK 0
#endif
#define REPS(k) (1 + ((REP_MASK >> (k)) & 1))
typedef const __attribute__((address_space(4))) Params KParams;
__device__ __forceinline__ Params load_params() {
    Params r{};
#if defined(__HIP_DEVICE_COMPILE__)
    KParams* k = (KParams*)__builtin_amdgcn_kernarg_segment_ptr(); asm volatile("" : "+s"(k));
#pragma unroll
    for (int i = 0; i < 24; ++i) r.in[i] = k->in[i];
    r.out = k->out; r.ws = k->ws;
#endif
    return r;
}
__global__ void __launch_bounds__(512, 2) fwd_kernel(Params p_unused) {
    extern __shared__ __attribute__((aligned(16))) unsigned char smem[];
    cg::grid_group grid = cg::this_grid();
    unsigned bgen = 0; (void)bgen;
    volatile LAS unsigned* xst = (volatile LAS unsigned*)((LAS unsigned char*)smem + 147200);
    if (threadIdx.x == 0) { xst[0] = 0u; xst[1] = 0u; }
    const unsigned xcc = xb_xcc_id();
#define XBAR_WORDS ((unsigned*)(((const KParams*)__builtin_amdgcn_kernarg_segment_ptr())->ws + WS_CTL) + 4096)
    if (threadIdx.x == 0) (void)xb_add(&XBAR_WORDS[XB_XCNT(xcc)], 1u);
    __syncthreads();
#define GBAR() xcd_barrier(XBAR_WORDS, xcc, xst)
#define PHASE_ENV \
    Params p = load_params(); \
    Ctx C; { int t_ = threadIdx.x; asm volatile("" : "+v"(t_)); int b_ = blockIdx.x; asm volatile("" : "+s"(b_)); C.tid = t_; C.lane = t_ & 63; C.wave = __builtin_amdgcn_readfirstlane(t_ >> 6); \
      C.gw = b_ * 8 + C.wave; C.ngw = gridDim.x * 8; C.lds = (LAS unsigned char*)smem; } \
    unsigned char* ws = p.ws; unsigned* ctl = (unsigned*)(ws + WS_CTL); float* mod = (float*)(ws + WS_MOD); float* stats = (float*)(ws + WS_STATS); \
    bf16_t* hb = (bf16_t*)(ws + WS_HB); float* xc = (float*)(ws + WS_XC); const int G = gridDim.x; const int cblk = C.gw >> 3; \
    (void)ctl; (void)mod; (void)stats; (void)hb; (void)xc; (void)G; (void)cblk;
    { PHASE_ENV
      if (PH(0)) phase_ada(p, C); }
#ifdef PROBE_SYNC
    for (int q_ = 0; q_ < 20; ++q_) grid.sync();
#endif
#ifdef PROBE_ADA
    GBAR(); { PHASE_ENV phase_ada(p, C); }
#endif
    if (((const KParams*)__builtin_amdgcn_kernarg_segment_ptr())->out == nullptr) grid.sync();
    GBAR();
    for (int l_ = 0; l_ < 2; ++l_) {
        int l = l_; asm volatile("" : "+s"(l));
        { PHASE_ENV
        if (PH(1)) convert_group1(p, l, C);
        if (PH(2)) { RowArgs a;
          a.x_lat = l == 0 ? p.in[0] : p.out; a.x_ctx = l == 0 ? p.in[2] : xc; a.xo_lat = l == 0 ? nullptr : p.out; a.xo_ctx = l == 0 ? nullptr : xc;
          a.delta = l == 0 ? nullptr : hb + 1024; a.dstats = stats; a.gpost = p.in[9]; a.modg = mod; a.gate_idx = 5;
          a.gpre = p.in[6] + l * 1024; a.modh = mod + (size_t)l * 17 * 6144; a.sh_idx = 0; a.sc_idx = 1; a.hout = hb; a.skip_ctx = 0;
          phase_rows(a, C); } }
        GBAR();
        for (int rep_ = 0; rep_ < REPS(3); ++rep_) { if (rep_) GBAR(); PHASE_ENV Sched S; S.A = (const char*)hb; S.B = (const char*)(ws + WS_WIN); S.a_tile = (size_t)256 * HBP * 2; S.b_tile = (size_t)256 * 1024 * 2; S.nM = 144; S.nN = 12; S.nt = 16; S.G = G; S.c = cblk; S.mode = 0; S.skip_ctx = 0; S.A2 = S.A3 = S.A4 = nullptr;
          EpiStore<0> E{ws, nullptr, 0, stats};
          pg8::gemm_phase(C.lds, HBP, 1024, S, E); }
        GBAR();
        for (int rep_ = 0; rep_ < REPS(4); ++rep_) { if (rep_) GBAR(); PHASE_ENV Sched S; S.A = (const char*)(hb + 1024); S.A2 = (const char*)(hb + 1408); S.B = (const char*)(ws + WS_WUQ); S.A3 = (const char*)(ws + WS_WUKV); S.A4 = nullptr;
          S.a_tile = (size_t)256 * HBP * 2; S.b_tile = (size_t)256 * 384 * 2; S.nM = 144; S.nN = 7; S.nt = 6; S.G = G; S.c = cblk; S.mode = 1; S.skip_ctx = 0;
          EpiUp E{ws};
          pg8::gemm_phase(C.lds, HBP, 384, S, E); }
        if (PH(5)) { PHASE_ENV phase_prep(p, l, C); }
        GBAR();
        if (PH(6)) { PHASE_ENV phase_mix(p, l, C, ctl + 64 * l); }
#if (REP_MASK >> 6) & 1
        GBAR(); { PHASE_ENV phase_mix(p, l, C, ctl + 64 * (2 + l), 3); }
#endif
        GBAR();
        for (int rep_ = 0; rep_ < REPS(7); ++rep_) { if (rep_) GBAR(); PHASE_ENV Sched S; S.A = (const char*)hb; S.A2 = (const char*)(hb + 1024); S.A3 = (const char*)(hb + 1536); S.A4 = (const char*)((bf16_t*)(ws + WS_MB) + 1024); S.B = (const char*)(ws + WS_WMG);
          S.a_tile = (size_t)256 * HBP * 2; S.b_tile = 0; S.nM = l == 0 ? 144 : 128; S.nN = 4; S.nt = 16; S.G = G; S.c = cblk; S.mode = 2; S.skip_ctx = l;
          EpiMerge E{ws};
          pg8::gemm_phase(C.lds, HBP, 1536, S, E); }
        GBAR();
        for (int rep_ = 0; rep_ < REPS(8); ++rep_) { if (rep_) GBAR(); PHASE_ENV Sched S; S.A = (const char*)(ws + WS_MB); S.B = (const char*)(ws + WS_WOUT); S.a_tile = (size_t)256 * MBP * 2; S.b_tile = (size_t)256 * 1024 * 2; S.nM = l == 0 ? 144 : 128; S.nN = 4; S.nt = 16; S.G = G; S.c = cblk; S.mode = 0; S.skip_ctx = l; S.A2 = S.A3 = S.A4 = nullptr;
          EpiStore<1> E{ws, hb + 1024, HBP, stats};
          pg8::gemm_phase(C.lds, MBP, 1024, S, E); }
        GBAR();
        { PHASE_ENV
        if (PH(9)) convert_group2(p, l, C);
        if (PH(10)) { RowArgs a;
          a.x_lat = l == 0 ? p.in[0] : p.out; a.x_ctx = l == 0 ? p.in[2] : xc; a.xo_lat = p.out; a.xo_ctx = xc;
          a.delta = hb + 1024; a.dstats = stats; a.gpost = p.in[7] + l * 1024; a.modg = mod + (size_t)l * 17 * 6144; a.gate_idx = 2;
          a.gpre = p.in[8] + l * 1024; a.modh = mod + (size_t)l * 17 * 6144; a.sh_idx = 3; a.sc_idx = 4; a.hout = hb; a.skip_ctx = l;
          phase_rows(a, C); } }
        GBAR();
        for (int rep_ = 0; rep_ < REPS(11); ++rep_) { if (rep_) GBAR(); PHASE_ENV Sched S; S.A = (const char*)hb; S.B = (const char*)(ws + WS_WM1); S.a_tile = (size_t)256 * HBP * 2; S.b_tile = (size_t)256 * 1024 * 2; S.nM = l == 0 ? 144 : 128; S.nN = 16; S.nt = 16; S.G = G; S.c = cblk; S.mode = 0; S.skip_ctx = l; S.A2 = S.A3 = S.A4 = nullptr;
          EpiStore<2> E{ws, (bf16_t*)(ws + WS_HID), HIDP, nullptr};
          pg8::gemm_phase(C.lds, HBP, 1024, S, E); }
        GBAR();
        for (int rep_ = 0; rep_ < REPS(12); ++rep_) { if (rep_) GBAR(); PHASE_ENV Sched S; S.A = (const char*)(ws + WS_HID); S.B = (const char*)(ws + WS_WM2); S.a_tile = (size_t)256 * HIDP * 2; S.b_tile = (size_t)256 * 4096 * 2; S.nM = l == 0 ? 144 : 128; S.nN = 4; S.nt = 64; S.G = G; S.c = cblk; S.mode = 0; S.skip_ctx = l; S.A2 = S.A3 = S.A4 = nullptr;
          EpiStore<1> E{ws, hb + 1024, HBP, stats};
          pg8::gemm_phase(C.lds, HIDP, 4096, S, E); }
        GBAR();
    }
    if (PH(13)) { PHASE_ENV RowArgs a;
      a.x_lat = p.out; a.x_ctx = xc; a.xo_lat = p.out; a.xo_ctx = nullptr;
      a.delta = hb + 1024; a.dstats = stats; a.gpost = p.in[9] + 1024; a.modg = mod + (size_t)17 * 6144; a.gate_idx = 5;
      a.gpre = nullptr; a.modh = nullptr; a.sh_idx = 0; a.sc_idx = 0; a.hout = nullptr; a.skip_ctx = 1;
      phase_rows(a, C); }
}

extern "C" void kernel_launch(void* const* d_in, const int* in_sizes, int n_in, void* d_out, int out_size, void* d_ws, size_t ws_size, hipStream_t stream) {
    static int grid = 0;
    if (grid == 0) {
        if (n_in != 24 || ws_size < WS_END) { fprintf(stderr, "kernel_launch: unexpected n_in %d or ws_size %zu (need %zu)\n", n_in, ws_size, (size_t)WS_END); grid = -1; return; }
        int dev = 0, cus = 0, per_cu = 0;
        (void)hipGetDevice(&dev);
        (void)hipDeviceGetAttribute(&cus, hipDeviceAttributeMultiprocessorCount, dev);
        (void)hipFuncSetAttribute((const void*)fwd_kernel, hipFuncAttributeMaxDynamicSharedMemorySize, LDS_BYTES);
        (void)hipOccupancyMaxActiveBlocksPerMultiprocessor(&per_cu, (const void*)fwd_kernel, 512, LDS_BYTES);
        if (per_cu < 1) { fprintf(stderr, "kernel_launch: occupancy query says %d blocks per CU\n", per_cu); per_cu = 1; }
        (void)hipGetLastError();
        grid = cus * 1;
    }
    if (grid < 0) return;
    Params p{};
    for (int i = 0; i < 24; ++i) p.in[i] = (const float*)d_in[i];
    p.out = (float*)d_out; p.ws = (unsigned char*)d_ws;
    (void)hipMemsetAsync((char*)d_ws + WS_CTL, 0, 65536, stream);
    void* args[] = {&p};
    hipError_t e = hipLaunchCooperativeKernel((const void*)fwd_kernel, dim3(grid), dim3(512), args, LDS_BYTES, stream);
    if (e != hipSuccess) fprintf(stderr, "cooperative launch failed: %s (grid %d)\n", hipGetErrorString(e), grid);
}
```

```cpp
#include <hip/hip_runtime.h>
#include <hip/hip_cooperative_groups.h>
#include <cstdio>
#include <cstdint>
namespace cg = cooperative_groups;

#define LAS __attribute__((address_space(3)))
typedef unsigned short bf16_t;
typedef short bf16x8 __attribute__((ext_vector_type(8)));
typedef short s16x4 __attribute__((ext_vector_type(4)));
typedef float f32x4 __attribute__((ext_vector_type(4)));
typedef unsigned u32x4 __attribute__((ext_vector_type(4)));
typedef unsigned u32x2 __attribute__((ext_vector_type(2)));

constexpr int D = 1024, NB = 16, NLAT = 2048, NCTX = 256, RB = NLAT + NCTX, R = NB * RB;
constexpr int DIN = 6080, DFF = 4096;
constexpr float EPS = 1e-6f;
constexpr float LOG2E = 1.4426950408889634f;
constexpr float L2THETA = 13.287712379549449f;

constexpr size_t MiB = 1u << 20;
constexpr size_t WS_CTL = 0;
constexpr size_t WS_MOD = 1 * MiB;
constexpr size_t WS_WIN = 2 * MiB;
constexpr size_t WS_WUQ = 8 * MiB;
constexpr size_t WS_WUKV = 9 * MiB;
constexpr size_t WS_WMG = 10 * MiB;
constexpr size_t WS_WOUT = 19 * MiB;
constexpr size_t WS_XC = 21 * MiB;
constexpr size_t WS_STATS = 37 * MiB;
constexpr size_t WS_LR = 43 * MiB;
constexpr size_t WS_HB = 48 * MiB;
constexpr size_t WS_MB = 192 * MiB;
constexpr size_t WS_ZA = 336 * MiB;
constexpr size_t WS_ZB = 390 * MiB;
constexpr size_t WS_HID = 192 * MiB;
constexpr size_t WS_WM1 = 480 * MiB;
constexpr size_t WS_WM2 = 488 * MiB;
constexpr size_t WS_END = 498 * MiB;
constexpr int HBP = 2048, MBP = 2048, ZAP = 768, ZBP = 1536, HIDP = 4096;

struct Params { const float* in[24]; float* out; unsigned char* ws; };

typedef float f32x2_t __attribute__((ext_vector_type(2))); typedef __bf16 bf16x2_t __attribute__((ext_vector_type(2)));
__device__ __forceinline__ unsigned cvt_pk_bf16(float lo, float hi) { const f32x2_t v = {lo, hi}; const bf16x2_t b = __builtin_convertvector(v, bf16x2_t); return __builtin_bit_cast(unsigned, b); }
__device__ __forceinline__ float bf2f(unsigned short v) { return __uint_as_float(((unsigned)v) << 16); }
__device__ __forceinline__ float bflo(unsigned v) { return __uint_as_float(v << 16); }
__device__ __forceinline__ float bfhi(unsigned v) { return __uint_as_float(v & 0xffff0000u); }
__device__ __forceinline__ float max3f(float a, float b, float c) { return __builtin_fmaxf(__builtin_fmaxf(a, b), c); }
__device__ __forceinline__ float wave_sum(float v) {
#pragma unroll
    for (int o = 1; o < 64; o <<= 1) v += __shfl_xor(v, o);
    return v;
}
#define LDS_WAIT() asm volatile("s_waitcnt lgkmcnt(0)" ::: "memory")
#define XB_TMO      128
#define XB_XCNT(j)  (256  + 64 * (j))
#define XB_XSUB(j)  (1280 + 64 * (j))
#define XB_XGEN(j)  (2304 + 64 * (j))
#define XB_TOP      3328
#define XB_TOPGEN   3392
#define XCD_BAR_WORDS 3456
#define XB_SPIN_CAP (1u << 20)
__device__ __forceinline__ unsigned xb_ld(unsigned* p)              { return __hip_atomic_load(p, __ATOMIC_RELAXED, __HIP_MEMORY_SCOPE_AGENT); }
__device__ __forceinline__ unsigned xb_add(unsigned* p, unsigned v) { return __hip_atomic_fetch_add(p, v, __ATOMIC_RELAXED, __HIP_MEMORY_SCOPE_AGENT); }
__device__ __forceinline__ unsigned xb_xcc_id() { return (unsigned)__builtin_amdgcn_s_getreg((3 << 11) | 20) & 0xFu; }
#define XB_SPIN(cond, bar) do { unsigned _sp = 0; while (cond) { __builtin_amdgcn_s_sleep(1); \
    if ((++_sp & 255u) == 0u) { if (xb_ld(&(bar)[XB_TMO])) break; if (_sp > XB_SPIN_CAP) { atomicAdd(&(bar)[XB_TMO], 1u); break; } } } } while (0)
__device__ __forceinline__ void xcd_barrier_complete(unsigned* bar, unsigned x, unsigned& nloc, unsigned& nx) {
    const unsigned G = gridDim.x * gridDim.y * gridDim.z;
    unsigned sum, cnt, mine, sp = 0u;
    for (;;) {
        sum = 0u; cnt = 0u; mine = 0u;
#pragma unroll
        for (unsigned j = 0; j < 16; ++j) { const unsigned c = xb_ld(&bar[XB_XCNT(j)]); sum += c; cnt += (c > 0u) ? 1u : 0u; mine = (j == x) ? c : mine; }
        if (sum == G) break;
        __builtin_amdgcn_s_sleep(1);
        if ((++sp & 255u) == 0u) { if (xb_ld(&bar[XB_TMO])) break; if (sp > XB_SPIN_CAP) { atomicAdd(&bar[XB_TMO], 1u); break; } }
    }
    nloc = mine > 0u ? mine : 1u; nx = cnt > 0u ? cnt : 1u;
}
__device__ __forceinline__ void xcd_barrier(unsigned* bar, unsigned x, volatile LAS unsigned* st) {
    asm volatile("s_waitcnt vmcnt(0) lgkmcnt(0)" ::: "memory");
    __syncthreads();
    if (threadIdx.x == 0) {
        __builtin_amdgcn_s_waitcnt(0);
        unsigned nloc = st[0], nx = st[1];
        if (nloc == 0u) { xcd_barrier_complete(bar, x, nloc, nx); st[0] = nloc; st[1] = nx; }
        const unsigned old = xb_add(&bar[XB_XSUB(x)], 1u);
        const unsigned gen = old / nloc;
        if (old + 1u == (gen + 1u) * nloc) {
            __builtin_amdgcn_fence(__ATOMIC_RELEASE, "agent");
            asm volatile("s_waitcnt vmcnt(0)" ::: "memory");
            const unsigned og = xb_add(&bar[XB_TOP], 1u);
            const unsigned tg = og / nx;
            if (og + 1u == (tg + 1u) * nx) xb_add(&bar[XB_TOPGEN], 1u);
            else XB_SPIN(xb_ld(&bar[XB_TOPGEN]) == tg, bar);
            __builtin_amdgcn_fence(__ATOMIC_ACQUIRE, "agent");
            xb_add(&bar[XB_XGEN(x)], 1u);
            asm volatile("s_waitcnt vmcnt(0)" ::: "memory");
        } else {
            XB_SPIN(xb_ld(&bar[XB_XGEN(x)]) == gen, bar);
            __builtin_amdgcn_fence(__ATOMIC_ACQUIRE, "agent");
            asm volatile("s_waitcnt vmcnt(0)" ::: "memory");
        }
    }
    __syncthreads();
}
__device__ __forceinline__ void grid_bar(unsigned* cnt, unsigned& gen) {
    asm volatile("s_waitcnt vmcnt(0) lgkmcnt(0)" ::: "memory");
    __syncthreads();
    gen += 1;
    if (threadIdx.x == 0) {
        __builtin_amdgcn_fence(__ATOMIC_RELEASE, "agent");
        asm volatile("s_waitcnt vmcnt(0)" ::: "memory");
        __hip_atomic_fetch_add(cnt, 1u, __ATOMIC_RELAXED, __HIP_MEMORY_SCOPE_AGENT);
        const unsigned target = gen * gridDim.x;
        while (__hip_atomic_load(cnt, __ATOMIC_RELAXED, __HIP_MEMORY_SCOPE_AGENT) < target) __builtin_amdgcn_s_sleep(1);
        __builtin_amdgcn_fence(__ATOMIC_ACQUIRE, "agent");
        asm volatile("s_waitcnt vmcnt(0)" ::: "memory");
    }
    __syncthreads();
}

namespace pg8 {
constexpr int BM = 256, BK = 64, HALF = 128, HTB = HALF * BK * 2, STAGE_BYTES = 8 * HTB;
__device__ __forceinline__ int lds_byte(int r, int c) { const int st = (r >> 4) * 2 + (c >> 5), rr = r & 15, cc = c & 31, ob = rr * 64 + cc * 2; return st * 1024 + (ob ^ (((ob >> 9) & 1) << 5)); }
__device__ __forceinline__ void stage_rc(int b, int& R_, int& C_) { const int st = b / 1024, sb = b % 1024, swz = sb ^ (((sb >> 9) & 1) << 5); R_ = (st >> 1) * 16 + swz / 64; C_ = (st & 1) * 32 + (swz % 64) / 2; }
__device__ __forceinline__ int perm32(int rho) { const int n = rho >> 4, i = rho & 15; return 8 * (i >> 2) + 4 * n + (i & 3); }

struct Unit { const char* a; const char* b; int nt; int pm, pn, kind; };
typedef f32x4 Acc[2][2][4][2];
__device__ __forceinline__ void zero_acc(Acc& acc) {
#pragma unroll
    for (int a = 0; a < 2; ++a)
#pragma unroll
        for (int b = 0; b < 2; ++b)
#pragma unroll
            for (int m = 0; m < 4; ++m)
#pragma unroll
                for (int n = 0; n < 2; ++n) acc[a][b][m][n] = (f32x4){0.f, 0.f, 0.f, 0.f};
}

template <class Epi, class Sched>
__device__ __forceinline__ void gemm_phase(LAS unsigned char* lds, const int lda, const int ldb, const Sched& S, const Epi& E) {
    int tid_ = threadIdx.x; asm volatile("" : "+v"(tid_));
    const int tid = tid_, wid = __builtin_amdgcn_readfirstlane(tid >> 6), lane = tid & 63, wr = wid >> 2, wc = wid & 3, fr = lane & 15, fq = lane >> 4;
    unsigned voffA[2], voffB[2];
#pragma unroll
    for (int i = 0; i < 2; ++i) { int R_, C_; stage_rc(tid * 16 + i * 8192, R_, C_); const int Rb = (R_ & ~31) + perm32(R_ & 31);
        voffA[i] = (unsigned)(R_ * lda + C_) * 2u; voffB[i] = (unsigned)(Rb * ldb + C_) * 2u; }
    const size_t kstep = (size_t)(BK * 2);
    const size_t hstepA = (size_t)HALF * lda * 2, hstepB = (size_t)HALF * ldb * 2;
    const unsigned ldsw = (unsigned)wid * 1024u;
    const int aoff = lds_byte(wr * 64 + fr, fq * 8), boff = lds_byte(wc * 32 + fr, fq * 8);
#define PG8_SA(b, h) (((b) * 2 + (h)) * HTB)
#define PG8_SB(b, h) ((4 + (b) * 2 + (h)) * HTB)
#define PG8_STAGE(bufoff, gbase, voff) do { _Pragma("unroll") for (int _i = 0; _i < 2; ++_i) \
        __builtin_amdgcn_global_load_lds((const unsigned*)((const char*)(gbase) + (voff)[_i]), (LAS unsigned*)(lds + (bufoff) + ldsw + _i * 8192), 16, 0, 0); } while (0)
#define PG8_LDA(dst, b, h) do { _Pragma("unroll") for (int m = 0; m < 4; ++m) _Pragma("unroll") for (int k = 0; k < 2; ++k) dst[m][k] = *(const LAS bf16x8*)(lds + PG8_SA(b, h) + aoff + m * 2048 + k * 1024); } while (0)
#define PG8_LDB(dst, b, h) do { _Pragma("unroll") for (int n = 0; n < 2; ++n) _Pragma("unroll") for (int k = 0; k < 2; ++k) dst[n][k] = *(const LAS bf16x8*)(lds + PG8_SB(b, h) + boff + n * 2048 + k * 1024); } while (0)
#define PG8_MMA(ai, bj, At, Bt) do { __builtin_amdgcn_s_setprio(1); _Pragma("unroll") for (int m = 0; m < 4; ++m) _Pragma("unroll") for (int n = 0; n < 2; ++n) _Pragma("unroll") for (int k = 0; k < 2; ++k) \
        acc[ai][bj][m][n] = __builtin_amdgcn_mfma_f32_16x16x32_bf16(Bt[n][k], At[m][k], acc[ai][bj][m][n], 0, 0, 0); __builtin_amdgcn_s_setprio(0); } while (0)
#define PG8_WAIT_V(n) asm volatile("s_waitcnt vmcnt(" #n ")" ::: "memory")
#define PG8_WAIT_L(n) asm volatile("s_waitcnt lgkmcnt(" #n ")" ::: "memory")
#define PG8_BAR __builtin_amdgcn_s_barrier()
#define PG8_SCHED __builtin_amdgcn_sched_barrier(0)
    Unit cur, nxt; int ui = 0;
    if (!S.next(0, cur)) return;
    Acc acc; zero_acc(acc);
    bf16x8 At[4][2], B0[2][2], B1[2][2];
    const char* cA = cur.a; const char* cB = cur.b;
    PG8_STAGE(PG8_SB(0, 0), cB, voffB); PG8_STAGE(PG8_SB(0, 1), cB + hstepB, voffB); PG8_STAGE(PG8_SA(0, 0), cA, voffA); PG8_STAGE(PG8_SA(0, 1), cA + hstepA, voffA);
    if (wr == 1) PG8_BAR;
    PG8_WAIT_V(2); PG8_BAR;
    PG8_STAGE(PG8_SB(1, 0), cB + kstep, voffB); PG8_STAGE(PG8_SA(1, 0), cA + kstep, voffA); PG8_STAGE(PG8_SB(1, 1), cB + hstepB + kstep, voffB);
    PG8_WAIT_V(6); PG8_BAR;
    for (;;) {
        const bool has_next = S.next(ui + 1, nxt);
        const char* nA = has_next ? nxt.a : cA; const char* nB = has_next ? nxt.b : cB;
        const int nt = cur.nt;
        for (int t = 0; t < nt; t += 2) {
            const bool last = (t == nt - 2);
            const char* a1 = cA + (size_t)(t + 1) * kstep;
            const char* a2 = last ? nA : cA + (size_t)(t + 2) * kstep; const char* b2 = last ? nB : cB + (size_t)(t + 2) * kstep;
            const char* a3 = a2 + kstep; const char* b3 = b2 + kstep;
            PG8_LDB(B0, 0, 0); PG8_LDB(B1, 0, 1); PG8_SCHED; PG8_LDA(At, 0, 0); PG8_STAGE(PG8_SA(1, 1), a1 + hstepA, voffA);
            PG8_WAIT_V(8); PG8_WAIT_L(0); PG8_BAR; PG8_MMA(0, 0, At, B0); PG8_MMA(0, 1, At, B1); PG8_BAR; PG8_SCHED;
            PG8_LDA(At, 0, 1); PG8_STAGE(PG8_SB(0, 0), b2, voffB); PG8_STAGE(PG8_SB(0, 1), b2 + hstepB, voffB); PG8_STAGE(PG8_SA(0, 0), a2, voffA);
            PG8_WAIT_V(8); PG8_WAIT_L(0); PG8_BAR; PG8_MMA(1, 0, At, B0); PG8_MMA(1, 1, At, B1); PG8_BAR; PG8_SCHED;
            PG8_LDB(B0, 1, 0); PG8_LDB(B1, 1, 1); PG8_SCHED; PG8_LDA(At, 1, 0); PG8_STAGE(PG8_SA(0, 1), a2 + hstepA, voffA);
            PG8_WAIT_V(8); PG8_WAIT_L(0); PG8_BAR; PG8_MMA(0, 0, At, B0); PG8_MMA(0, 1, At, B1); PG8_BAR; PG8_SCHED;
            PG8_LDA(At, 1, 1); PG8_STAGE(PG8_SB(1, 0), b3, voffB); PG8_STAGE(PG8_SB(1, 1), b3 + hstepB, voffB); PG8_STAGE(PG8_SA(1, 0), a3, voffA);
            PG8_WAIT_V(8); PG8_WAIT_L(0); PG8_BAR; PG8_MMA(1, 0, At, B0); PG8_MMA(1, 1, At, B1); PG8_BAR; PG8_SCHED;
        }
        if (wr == 0) PG8_BAR;
        E(acc, cur, wr, wc, fr, fq);
        if (!has_next) break;
        cur = nxt; cA = nA; cB = nB; ++ui;
        if (wr == 1) PG8_BAR;
    }
    PG8_WAIT_V(0);
    PG8_BAR;
#undef PG8_SA
#undef PG8_SB
#undef PG8_STAGE
#undef PG8_LDA
#undef PG8_LDB
#undef PG8_MMA
#undef PG8_WAIT_V
#undef PG8_WAIT_L
#undef PG8_BAR
#undef PG8_SCHED
}
}

struct Sched {
    const char* A; const char* B; size_t a_tile, b_tile;
    int nM, nN, nt, G, c, mode, skip_ctx;
    const char* A2; const char* A3; const char* A4;
    __device__ __forceinline__ int map_pm(int pm) const { return skip_ctx ? (pm >> 3) * 9 + 1 + (pm & 7) : pm; }
    __device__ __forceinline__ bool next(int i, pg8::Unit& u) const {
        if (mode == 0) {
            const int nwg = nM * nN; const long L = (long)i * G + c; if (L >= nwg) return false;
            int wgid = (int)L; { const int q = nwg / 8, r = nwg % 8, xcd = wgid % 8, off = wgid / 8; wgid = (xcd < r ? xcd * (q + 1) : r * (q + 1) + (xcd - r) * q) + off; }
            const int nig = 8 * nN, gid = wgid / nig, fm = gid * 8, gsz = (nM - fm) < 8 ? (nM - fm) : 8;
            const int pm = map_pm(fm + ((wgid % nig) % gsz)), pn = (wgid % nig) / gsz;
            u.pm = pm; u.pn = pn; u.kind = 0; u.nt = nt; u.a = A + (size_t)pm * a_tile; u.b = B + (size_t)pn * b_tile; return true;
        } else if (mode == 1) {
            const long L = (long)i * G + c; if (L >= 144 * 7) return false;
            const int pm = (int)(L / 7), s = (int)(L % 7);
            u.pm = pm;
            if (s < 3) { u.kind = 0; u.pn = s; u.nt = 6; u.a = A + (size_t)pm * a_tile; u.b = B + (size_t)s * b_tile; }
            else { u.kind = 1; u.pn = s - 3; u.nt = 4; u.a = A2 + (size_t)pm * a_tile; u.b = (const char*)A3 + (size_t)(s - 3) * b_tile; }
            return true;
        } else {
            const int ntile = nM * 4; const long L = (long)(i / 6) * G + c; if (L >= ntile) return false;
            const int sub = i % 6; const int pm = map_pm((int)(L >> 2)), pn = (int)(L & 3);
            u.pm = pm; u.pn = pn; u.kind = sub;
            const int z = sub >> 1;
            const char* bb = B + ((size_t)z * 1024 + (size_t)pn * 256) * 1536 * 2;
            if ((sub & 1) == 0) { u.a = A + (size_t)pm * a_tile; u.b = bb; u.nt = 16; }
            else { const char* ab = (z == 2) ? A4 : A2 + (size_t)z * 1024; u.a = ab + (size_t)pm * a_tile; u.b = bb + 1024 * 2; u.nt = 8; }
            return true;
        }
    }
};

__device__ __forceinline__ void row_info(int r, int& b, int& j) { b = r / RB; j = r - b * RB; }

template <int MODE> struct EpiStore {
    unsigned char* ws; bf16_t* dst; int dpitch; float* stats;
    __device__ __forceinline__ void operator()(pg8::Acc& acc, const pg8::Unit& u, int wr, int wc, int fr, int fq) const {
        const int row0 = u.pm * 256 + wr * 64 + fr;
#pragma unroll
        for (int bj = 0; bj < 2; ++bj) {
            const int n0 = u.pn * 256 + bj * 128 + wc * 32;
            bf16_t* base; int pitch; int sidx = -1; float* lrp = nullptr;
            if (MODE == 0) {
                if (n0 < 768) { base = (bf16_t*)(ws + WS_ZA) + n0; pitch = ZAP; if (n0 < 640) sidx = n0 >> 5; }
                else if (n0 < 2304) { base = (bf16_t*)(ws + WS_ZB) + (n0 - 768); pitch = ZBP; }
                else if (n0 < 2944) { base = (bf16_t*)(ws + WS_HB) + 1024 + (n0 - 2304); pitch = HBP; sidx = (n0 >> 5) - 52; }
                else if (n0 == 2944) { base = (bf16_t*)(ws + WS_MB) + 1792; pitch = MBP; }
                else if (n0 == 2976) { base = nullptr; pitch = 0; lrp = (float*)(ws + WS_LR); }
                else { base = nullptr; pitch = 0; }
            } else { base = dst + n0; pitch = dpitch; sidx = n0 >> 5; }
#pragma unroll
            for (int ai = 0; ai < 2; ++ai)
#pragma unroll
                for (int m = 0; m < 4; ++m) {
                    const int row = row0 + ai * 128 + m * 16;
                    f32x4 v0 = acc[ai][bj][m][0], v1 = acc[ai][bj][m][1];
                    if (MODE == 2) {
#pragma unroll
                        for (int e = 0; e < 4; ++e) { float a = fmaxf(v0[e], 0.f), b = fmaxf(v1[e], 0.f); v0[e] = a * a; v1[e] = b * b; }
                    }
                    if (MODE != 2) {
                        if (sidx >= 0) {
                            float s = (v0[0] * v0[0] + v0[1] * v0[1]) + (v0[2] * v0[2] + v0[3] * v0[3]) + (v1[0] * v1[0] + v1[1] * v1[1]) + (v1[2] * v1[2] + v1[3] * v1[3]);
                            s += __shfl_xor(s, 16); s += __shfl_xor(s, 32);
                            if (fq == 0) stats[(size_t)row * (MODE == 0 ? 40 : 32) + sidx] = s;
                        }
                    }
                    if (base) {
                        u32x4 w; w.x = cvt_pk_bf16(v0[0], v0[1]); w.y = cvt_pk_bf16(v0[2], v0[3]); w.z = cvt_pk_bf16(v1[0], v1[1]); w.w = cvt_pk_bf16(v1[2], v1[3]);
                        *(u32x4*)(base + (size_t)row * pitch + 8 * fq) = w;
                    } else if (MODE == 0 && lrp) {
                        float* o = lrp + (size_t)row * 32 + 8 * fq; *(f32x4*)o = v0; *(f32x4*)(o + 4) = v1;
                    }
                    asm volatile("" ::: "memory");
                }
        }
        pg8::zero_acc(acc);
    }
};

struct EpiUp {
    unsigned char* ws;
    __device__ __forceinline__ void operator()(pg8::Acc& acc, const pg8::Unit& u, int wr, int wc, int fr, int fq) const {
        const int row0 = u.pm * 256 + wr * 64 + fr;
        const float* stats = (const float*)(ws + WS_STATS);
        bf16_t* mb = (bf16_t*)(ws + WS_MB);
        const float qs = 0.10206207261596577f * LOG2E;
#pragma unroll
        for (int ai = 0; ai < 2; ++ai)
#pragma unroll
            for (int m = 0; m < 4; ++m) {
                const int row = row0 + ai * 128 + m * 16;
                const float* sp = stats + (size_t)row * 40 + (u.kind == 0 ? 20 : 32);
                float ss; float rs;
                if (u.kind == 0) { f32x4 a = *(const f32x4*)sp, b = *(const f32x4*)(sp + 4), c = *(const f32x4*)(sp + 8);
                    ss = (a[0] + a[1] + a[2] + a[3]) + (b[0] + b[1] + b[2] + b[3]) + (c[0] + c[1] + c[2] + c[3]); rs = rsqrtf(ss * (1.f / 384.f) + EPS) * qs; }
                else { f32x4 a = *(const f32x4*)sp, b = *(const f32x4*)(sp + 4); ss = (a[0] + a[1] + a[2] + a[3]) + (b[0] + b[1] + b[2] + b[3]); rs = rsqrtf(ss * (1.f / 256.f) + EPS); }
                int bb, jj; row_info(row, bb, jj);
                const bool lat = jj >= NCTX; const int tkn = jj - NCTX; const float grow = (float)(tkn >> 6), gcol = (float)(tkn & 63);
#pragma unroll
                for (int bj = 0; bj < 2; ++bj) {
                    const int n = u.pn * 256 + bj * 128 + wc * 32 + 8 * fq;
                    f32x4 v0 = acc[ai][bj][m][0] * rs, v1 = acc[ai][bj][m][1] * rs;
                    if (u.kind == 0 && n >= 512 && lat) {
                        const int e0 = (n - 512) & 31;
#pragma unroll
                        for (int pp = 0; pp < 4; ++pp) {
                            const int i = (e0 >> 1) + pp; const float pos = (i < 8) ? grow : gcol; const int f = i & 7;
                            float rev = pos * exp2f(-(float)f * (L2THETA / 8.f)) * 0.15915494309189535f; rev -= rintf(rev);
                            const float sn = __builtin_amdgcn_sinf(rev), cs = __builtin_amdgcn_cosf(rev);
                            float x0, x1;
                            if (pp == 0) { x0 = v0[0]; x1 = v0[1]; } else if (pp == 1) { x0 = v0[2]; x1 = v0[3]; } else if (pp == 2) { x0 = v1[0]; x1 = v1[1]; } else { x0 = v1[2]; x1 = v1[3]; }
                            const float y0 = x0 * cs - x1 * sn, y1 = x0 * sn + x1 * cs;
                            if (pp == 0) { v0[0] = y0; v0[1] = y1; } else if (pp == 1) { v0[2] = y0; v0[3] = y1; } else if (pp == 2) { v1[0] = y0; v1[1] = y1; } else { v1[2] = y0; v1[3] = y1; }
                        }
                    }
                    u32x4 w; w.x = cvt_pk_bf16(v0[0], v0[1]); w.y = cvt_pk_bf16(v0[2], v0[3]); w.z = cvt_pk_bf16(v1[0], v1[1]); w.w = cvt_pk_bf16(v1[2], v1[3]);
                    *(u32x4*)(mb + (size_t)row * MBP + (u.kind == 0 ? 1024 : 0) + n) = w;
                }
                asm volatile("" ::: "memory");
            }
        pg8::zero_acc(acc);
    }
};

struct EpiMerge {
    unsigned char* ws;
    __device__ __forceinline__ void operator()(pg8::Acc& acc, const pg8::Unit& u, int wr, int wc, int fr, int fq) const {
        u32x4* scr = (u32x4*)(ws + WS_ZB) + (size_t)blockIdx.x * (16 * 512) + threadIdx.x;
        const int z = u.kind >> 1;
        if ((u.kind & 1) == 0) {
            u32x4* sp = scr;
#pragma unroll
            for (int ai = 0; ai < 2; ++ai)
#pragma unroll
                for (int m = 0; m < 4; ++m)
#pragma unroll
                    for (int bj = 0; bj < 2; ++bj) {
                        float g[8];
#pragma unroll
                        for (int e = 0; e < 4; ++e) { g[e] = __builtin_amdgcn_rcpf(1.f + __expf(-acc[ai][bj][m][0][e])); g[4 + e] = __builtin_amdgcn_rcpf(1.f + __expf(-acc[ai][bj][m][1][e])); }
                        u32x4 w; w.x = cvt_pk_bf16(g[0], g[1]); w.y = cvt_pk_bf16(g[2], g[3]); w.z = cvt_pk_bf16(g[4], g[5]); w.w = cvt_pk_bf16(g[6], g[7]);
                        *sp = w; sp += 512; asm volatile("" : "+v"(sp) :: "memory");
                    }
        } else {
            const int row0 = u.pm * 256 + wr * 64 + fr;
            bf16_t* mo = (bf16_t*)(ws + WS_MB) + (size_t)row0 * MBP + u.pn * 256 + wc * 32 + 8 * fq;
            const u32x4* pa = scr;
#pragma unroll
            for (int g4 = 0; g4 < 4; ++g4) {
                u32x4 gv[4], mv[4];
#pragma unroll
                for (int k = 0; k < 4; ++k) { const int e = g4 * 4 + k, ai = e >> 3, m = (e >> 1) & 3, bj = e & 1;
                    gv[k] = __builtin_nontemporal_load(pa + k * 512);
                    if (z > 0) mv[k] = __builtin_nontemporal_load((const u32x4*)(mo + (size_t)(ai * 128 + m * 16) * MBP + bj * 128)); }
#pragma unroll
                for (int k = 0; k < 4; ++k) { const int e = g4 * 4 + k, ai = e >> 3, m = (e >> 1) & 3, bj = e & 1;
                    const f32x4 n0 = {bflo(gv[k].x), bfhi(gv[k].x), bflo(gv[k].y), bfhi(gv[k].y)}, n1 = {bflo(gv[k].z), bfhi(gv[k].z), bflo(gv[k].w), bfhi(gv[k].w)};
                    f32x4 v0 = acc[ai][bj][m][0] * n0, v1 = acc[ai][bj][m][1] * n1;
                    if (z > 0) { v0 += (f32x4){bflo(mv[k].x), bfhi(mv[k].x), bflo(mv[k].y), bfhi(mv[k].y)}; v1 += (f32x4){bflo(mv[k].z), bfhi(mv[k].z), bflo(mv[k].w), bfhi(mv[k].w)}; }
                    u32x4 w; w.x = cvt_pk_bf16(v0[0], v0[1]); w.y = cvt_pk_bf16(v0[2], v0[3]); w.z = cvt_pk_bf16(v1[0], v1[1]); w.w = cvt_pk_bf16(v1[2], v1[3]);
                    *(u32x4*)(mo + (size_t)(ai * 128 + m * 16) * MBP + bj * 128) = w; }
                pa += 4 * 512; asm volatile("" : "+v"(pa) :: "memory");
            }
        }
        pg8::zero_acc(acc);
    }
};

struct Ctx { int tid, lane, wave, gw, ngw; LAS unsigned char* lds; };

__device__ __forceinline__ void phase_ada(const Params& p, const Ctx& C) {
    LAS float* sil = (LAS float*)C.lds; LAS float* red = (LAS float*)(C.lds + 69632);
    const float* cv = p.in[1]; const float* cctx = p.in[3];
    for (int i = C.tid; i < 17 * 1024; i += 512) { const float v = (i < 16384) ? cv[i] : cctx[i - 16384]; sil[i] = v / (1.f + __expf(-v)); }
    __syncthreads();
    float* mod = (float*)(p.ws + WS_MOD);
    for (int cb = blockIdx.x; cb < 256; cb += gridDim.x) {
        const int l = cb >> 7, j0 = (cb & 127) * 48;
        const float* W = p.in[4] + (size_t)l * 1024 * 6144;
        const int cl = C.tid % 48, ks = C.tid / 48;
        float a[17];
#pragma unroll
        for (int r = 0; r < 17; ++r) a[r] = 0.f;
        if (ks < 10) {
            int k = ks;
            for (; k + 70 < 1024; k += 80) {
                float w[8];
#pragma unroll
                for (int q = 0; q < 8; ++q) w[q] = W[(size_t)(k + 10 * q) * 6144 + j0 + cl];
#pragma unroll
                for (int r = 0; r < 17; ++r) {
                    float t0 = sil[r * 1024 + k] * w[0] + sil[r * 1024 + k + 10] * w[1], t1 = sil[r * 1024 + k + 20] * w[2] + sil[r * 1024 + k + 30] * w[3];
                    float t2 = sil[r * 1024 + k + 40] * w[4] + sil[r * 1024 + k + 50] * w[5], t3 = sil[r * 1024 + k + 60] * w[6] + sil[r * 1024 + k + 70] * w[7];
                    a[r] += (t0 + t1) + (t2 + t3); }
            }
            for (; k < 1024; k += 10) { const float w = W[(size_t)k * 6144 + j0 + cl];
#pragma unroll
                for (int r = 0; r < 17; ++r) a[r] += sil[r * 1024 + k] * w; }
#pragma unroll
            for (int r = 0; r < 17; ++r) red[(ks * 17 + r) * 48 + cl] = a[r];
        }
        __syncthreads();
        for (int o = C.tid; o < 17 * 48; o += 512) { const int r = o / 48, cc = o % 48; float s = p.in[5][l * 6144 + j0 + cc];
            for (int k2 = 0; k2 < 10; ++k2) s += red[(k2 * 17 + r) * 48 + cc];
            mod[(size_t)(l * 17 + r) * 6144 + j0 + cc] = s; }
        __syncthreads();
    }
}

struct CvtJob { const float* src; int src_ld; bf16_t* dst; int dst_ld; int K; int N; int map; const float* kscale; };
__device__ __forceinline__ int srccol(int map, int n0) {
    if (map == 0) return n0;
    if (map == 1) { if (n0 < 1792) return n0; if (n0 < 2304) return 1824 + (n0 - 1792); if (n0 < 2688) return 2336 + (n0 - 2304); if (n0 < 2944) return 2720 + (n0 - 2688);
        if (n0 == 2944) return 2976; if (n0 == 2976) return 1792; return -1; }
    if (map == 2) { if (n0 < 512) return (n0 >> 6) * 96 + (n0 & 63); const int m = n0 - 512; return (m >> 5) * 96 + 64; }
    { if (n0 < 512) return (n0 >> 6) * 128 + (n0 & 63); const int m = n0 - 512; return (m >> 6) * 128 + 64 + (m & 63); }
}
__device__ __forceinline__ void cvt_item(const CvtJob& J, int item, LAS float* scr, int lane) {
    const int nblk = J.N / 32, kb = item / nblk, nb = item % nblk, k0 = 64 * kb, n0 = 32 * nb;
    const int sc = srccol(J.map, n0);
#pragma unroll
    for (int i = 0; i < 8; ++i) { const int kk = 8 * i + (lane >> 3), c4 = (lane & 7) * 4; f32x4 v = {0.f, 0.f, 0.f, 0.f};
        if (sc >= 0) { v = *(const f32x4*)(J.src + (size_t)(k0 + kk) * J.src_ld + sc + c4); if (J.kscale) v = v * J.kscale[k0 + kk]; }
        scr[kk * 33 + c4] = v[0]; scr[kk * 33 + c4 + 1] = v[1]; scr[kk * 33 + c4 + 2] = v[2]; scr[kk * 33 + c4 + 3] = v[3]; }
    LDS_WAIT(); asm volatile("" ::: "memory");
    const int c = lane & 7;
#pragma unroll
    for (int j = 0; j < 4; ++j) { const int n = (lane >> 3) + 8 * j; const LAS float* s = scr + (8 * c) * 33 + n;
        u32x4 o; o.x = cvt_pk_bf16(s[0 * 33], s[1 * 33]); o.y = cvt_pk_bf16(s[2 * 33], s[3 * 33]); o.z = cvt_pk_bf16(s[4 * 33], s[5 * 33]); o.w = cvt_pk_bf16(s[6 * 33], s[7 * 33]);
        *(u32x4*)(J.dst + (size_t)(n0 + n) * J.dst_ld + k0 + 8 * c) = o; }
    LDS_WAIT(); asm volatile("" ::: "memory");
}
__device__ __forceinline__ void run_cvt(const CvtJob& J, const Ctx& C) {
    LAS float* scr = (LAS float*)(C.lds + C.wave * 16384);
    const int items = (J.K / 64) * (J.N / 32);
    for (int it = C.gw; it < items; it += C.ngw) cvt_item(J, it, scr, C.lane);
}
__device__ __forceinline__ void convert_group1(const Params& p, int l, const Ctx& C) {
    unsigned char* ws = p.ws;
    { CvtJob J{p.in[10] + (size_t)l * D * DIN, DIN, (bf16_t*)(ws + WS_WIN), 1024, 1024, 3072, 1, nullptr}; run_cvt(J, C); }
    { CvtJob J{p.in[18] + (size_t)l * 384 * 768, 768, (bf16_t*)(ws + WS_WUQ), 384, 384, 768, 2, p.in[16] + l * 384}; run_cvt(J, C); }
    { CvtJob J{p.in[19] + (size_t)l * 256 * 1024, 1024, (bf16_t*)(ws + WS_WUKV), 384, 256, 1024, 3, p.in[17] + l * 256}; run_cvt(J, C); }
    for (int z = 0; z < 3; ++z) {
        { CvtJob J{p.in[10] + (size_t)l * D * DIN + 3008 + z * 1024, DIN, (bf16_t*)(ws + WS_WMG) + (size_t)z * 1024 * 1536, 1536, 1024, 1024, 0, nullptr}; run_cvt(J, C); }
        { CvtJob J{p.in[20] + ((size_t)l * 3 + z) * 512 * 1024, 1024, (bf16_t*)(ws + WS_WMG) + (size_t)z * 1024 * 1536 + 1024, 1536, 512, 1024, 0, nullptr}; run_cvt(J, C); }
    }
    { CvtJob J{p.in[21] + (size_t)l * D * D, 1024, (bf16_t*)(ws + WS_WOUT), 1024, 1024, 1024, 0, nullptr}; run_cvt(J, C); }
}
__device__ __forceinline__ void convert_group2(const Params& p, int l, const Ctx& C) {
    unsigned char* ws = p.ws;
    { CvtJob J{p.in[22] + (size_t)l * D * DFF, DFF, (bf16_t*)(ws + WS_WM1), 1024, 1024, 4096, 0, nullptr}; run_cvt(J, C); }
    { CvtJob J{p.in[23] + (size_t)l * DFF * D, 1024, (bf16_t*)(ws + WS_WM2), 4096, 4096, 1024, 0, nullptr}; run_cvt(J, C); }
}

struct RowArgs {
    const float* x_lat; const float* x_ctx; float* xo_lat; float* xo_ctx;
    const bf16_t* delta; const float* dstats; const float* gpost; const float* modg; int gate_idx;
    const float* gpre; const float* modh; int sh_idx, sc_idx; bf16_t* hout; int skip_ctx;
};
__device__ __forceinline__ void phase_rows(const RowArgs& a, const Ctx& C) {
    const int lane = C.lane;
    const int total = a.skip_ctx ? NB * NLAT : R;
    const int rpw = (total + C.ngw - 1) / C.ngw;
    const int i0 = C.gw * rpw, i1 = (i0 + rpw < total) ? i0 + rpw : total;
    int cur = -1;
    f32x4 vgate[4], vgpost[4], vgpre[4], vsh[4], vsc[4];
#pragma unroll
    for (int q = 0; q < 4; ++q) { vgate[q] = vgpost[q] = vgpre[q] = vsh[q] = vsc[q] = (f32x4){0.f, 0.f, 0.f, 0.f}; }
    if (a.delta) {
#pragma unroll
        for (int q = 0; q < 4; ++q) vgpost[q] = *(const f32x4*)(a.gpost + 4 * lane + 256 * q);
    }
    if (a.hout) {
#pragma unroll
        for (int q = 0; q < 4; ++q) vgpre[q] = *(const f32x4*)(a.gpre + 4 * lane + 256 * q);
    }
    for (int i = i0; i < i1; ++i) {
        int b, j;
        if (a.skip_ctx) { b = i >> 11; j = NCTX + (i & (NLAT - 1)); } else { b = i / RB; j = i - b * RB; }
        const int r = b * RB + j; const bool isctx = j < NCTX;
        const size_t xoff = isctx ? (size_t)(b * NCTX + j) * D : (size_t)(b * NLAT + (j - NCTX)) * D;
        const float* xin = (isctx ? a.x_ctx : a.x_lat) + xoff;
        const int mrow = isctx ? 16 : b;
        f32x4 x[4];
#pragma unroll
        for (int q = 0; q < 4; ++q) x[q] = *(const f32x4*)(xin + 4 * lane + 256 * q);
        u32x2 yv[4]; float ss = 0.f;
        if (a.delta) {
#pragma unroll
            for (int q = 0; q < 4; ++q) yv[q] = *(const u32x2*)(a.delta + (size_t)r * HBP + 4 * lane + 256 * q);
            ss = (lane < 32) ? a.dstats[(size_t)r * 32 + lane] : 0.f;
        }
        if (mrow != cur) {
            cur = mrow;
            if (a.delta) { const float* gt = a.modg + (size_t)mrow * 6144 + a.gate_idx * 1024;
#pragma unroll
                for (int q = 0; q < 4; ++q) vgate[q] = *(const f32x4*)(gt + 4 * lane + 256 * q); }
            if (a.hout) { const float* sh = a.modh + (size_t)mrow * 6144 + a.sh_idx * 1024; const float* sc = a.modh + (size_t)mrow * 6144 + a.sc_idx * 1024;
#pragma unroll
                for (int q = 0; q < 4; ++q) { vsh[q] = *(const f32x4*)(sh + 4 * lane + 256 * q); vsc[q] = *(const f32x4*)(sc + 4 * lane + 256 * q) + 1.f; } }
        }
        if (a.delta) {
            ss = wave_sum(ss);
            const float rs = rsqrtf(ss * (1.f / 1024.f) + EPS);
#pragma unroll
            for (int q = 0; q < 4; ++q) {
                x[q][0] += vgate[q][0] * (bflo(yv[q].x) * rs * vgpost[q][0]); x[q][1] += vgate[q][1] * (bfhi(yv[q].x) * rs * vgpost[q][1]);
                x[q][2] += vgate[q][2] * (bflo(yv[q].y) * rs * vgpost[q][2]); x[q][3] += vgate[q][3] * (bfhi(yv[q].y) * rs * vgpost[q][3]); }
        }
        float* xo = isctx ? a.xo_ctx : a.xo_lat;
        if (xo) {
#pragma unroll
            for (int q = 0; q < 4; ++q) *(f32x4*)(xo + xoff + 4 * lane + 256 * q) = x[q];
        }
        if (a.hout) {
            float s2 = 0.f;
#pragma unroll
            for (int q = 0; q < 4; ++q) s2 += (x[q][0] * x[q][0] + x[q][1] * x[q][1]) + (x[q][2] * x[q][2] + x[q][3] * x[q][3]);
            s2 = wave_sum(s2); const float rs = rsqrtf(s2 * (1.f / 1024.f) + EPS);
#pragma unroll
            for (int q = 0; q < 4; ++q) {
                const float h0 = (x[q][0] * rs * vgpre[q][0]) * vsc[q][0] + vsh[q][0], h1 = (x[q][1] * rs * vgpre[q][1]) * vsc[q][1] + vsh[q][1];
                const float h2 = (x[q][2] * rs * vgpre[q][2]) * vsc[q][2] + vsh[q][2], h3 = (x[q][3] * rs * vgpre[q][3]) * vsc[q][3] + vsh[q][3];
                u32x2 w; w.x = cvt_pk_bf16(h0, h1); w.y = cvt_pk_bf16(h2, h3);
                *(u32x2*)(a.hout + (size_t)r * HBP + 4 * lane + 256 * q) = w; }
        }
    }
}

__device__ __forceinline__ void phase_prep(const Params& p, int l, const Ctx& C) {
    const int lane = C.lane;
    bf16_t* za = (bf16_t*)(p.ws + WS_ZA); bf16_t* mb = (bf16_t*)(p.ws + WS_MB); const float* stats = (const float*)(p.ws + WS_STATS);
    const float* gq = p.in[11] + l * 64; const float* gk = p.in[12] + l * 64;
    const float qs = 0.125f * LOG2E;
    constexpr int NR = 4;
    for (int r0 = C.gw; r0 < R; r0 += NR * C.ngw) {
        unsigned v[NR][5]; float ssum[NR][5]; unsigned kr[NR];
#pragma unroll
        for (int q = 0; q < NR; ++q) { const int r = r0 + q * C.ngw;
            if (r < R) {
#pragma unroll
                for (int it = 0; it < 5; ++it) { const int col = 2 * (lane + 64 * it), head = col >> 6;
                    v[q][it] = *(const unsigned*)(za + (size_t)r * ZAP + col);
                    ssum[q][it] = stats[(size_t)r * 40 + 2 * head] + stats[(size_t)r * 40 + 2 * head + 1]; }
                kr[q] = (lane < 16) ? *(const unsigned*)(mb + (size_t)r * MBP + 1792 + 2 * lane) : 0u;
            }
        }
#pragma unroll
        for (int q = 0; q < NR; ++q) { const int r = r0 + q * C.ngw;
            if (r < R) {
                int b, j; row_info(r, b, j); const bool lat = j >= NCTX; const int tkn = j - NCTX; const float grow = (float)(tkn >> 6), gcol = (float)(tkn & 63);
#pragma unroll
                for (int it = 0; it < 5; ++it) {
                    const int col = 2 * (lane + 64 * it), head = col >> 6, i = (col & 63) >> 1;
                    const float rs = rsqrtf(ssum[q][it] * (1.f / 64.f) + EPS);
                    const float* g = head < 8 ? gq : gk;
                    float x0 = bflo(v[q][it]) * rs * g[2 * i], x1 = bfhi(v[q][it]) * rs * g[2 * i + 1];
                    if (lat) { const float pos = (i < 16) ? grow : gcol; const int f = i & 15;
                        float rev = pos * exp2f(-(float)f * (L2THETA / 16.f)) * 0.15915494309189535f; rev -= rintf(rev);
                        const float sn = __builtin_amdgcn_sinf(rev), cs = __builtin_amdgcn_cosf(rev);
                        const float y0 = x0 * cs - x1 * sn, y1 = x0 * sn + x1 * cs; x0 = y0; x1 = y1; }
                    if (head < 8) { x0 *= qs; x1 *= qs; }
                    *(unsigned*)(za + (size_t)r * ZAP + col) = cvt_pk_bf16(x0, x1);
                }
                if (lat && lane < 16) { const int i = lane;
                    const float x0 = bflo(kr[q]), x1 = bfhi(kr[q]); const float pos = (i < 8) ? grow : gcol; const int f = i & 7;
                    float rev = pos * exp2f(-(float)f * (L2THETA / 8.f)) * 0.15915494309189535f; rev -= rintf(rev);
                    const float sn = __builtin_amdgcn_sinf(rev), cs = __builtin_amdgcn_cosf(rev);
                    *(unsigned*)(mb + (size_t)r * MBP + 1792 + 2 * i) = cvt_pk_bf16(x0 * cs - x1 * sn, x0 * sn + x1 * cs); }
            }
        }
    }
}

__device__ __forceinline__ float xmax4(float m) {
    { auto r = __builtin_amdgcn_permlane16_swap(__float_as_uint(m), __float_as_uint(m), false, false); m = __builtin_fmaxf(__uint_as_float(r[0]), __uint_as_float(r[1])); }
    { auto r = __builtin_amdgcn_permlane32_swap(__float_as_uint(m), __float_as_uint(m), false, false); m = __builtin_fmaxf(__uint_as_float(r[0]), __uint_as_float(r[1])); }
    return m;
}
__device__ __forceinline__ float xsum4(float m) {
    { auto r = __builtin_amdgcn_permlane16_swap(__float_as_uint(m), __float_as_uint(m), false, false); m = __uint_as_float(r[0]) + __uint_as_float(r[1]); }
    { auto r = __builtin_amdgcn_permlane32_swap(__float_as_uint(m), __float_as_uint(m), false, false); m = __uint_as_float(r[0]) + __uint_as_float(r[1]); }
    return m;
}
template <bool DO_MAX>
__device__ __forceinline__ void attn_softmax(f32x4 (&s)[4], f32x4& lsum, float& dpend, bf16x8 (&pf)[2]) {
    if (DO_MAX) {
    float mx = max3f(s[0][0], s[0][1], s[0][2]); float mx2 = max3f(s[0][3], s[1][0], s[1][1]);
    mx = max3f(mx, s[1][2], s[1][3]); mx2 = max3f(mx2, s[2][0], s[2][1]);
    mx = max3f(mx, s[2][2], s[2][3]); mx2 = max3f(mx2, s[3][0], s[3][1]);
    mx = max3f(mx, s[3][2], s[3][3]); dpend = xmax4(__builtin_fmaxf(mx, mx2));
    } else { dpend = -1e30f; }
#pragma unroll
    for (int kt = 0; kt < 4; ++kt) {
#pragma unroll
        for (int e = 0; e < 4; ++e) s[kt][e] = __builtin_amdgcn_exp2f(s[kt][e]);
        lsum += s[kt]; }
#pragma unroll
    for (int kb2 = 0; kb2 < 2; ++kb2) {
        u32x4 w; w.x = cvt_pk_bf16(s[2 * kb2][0], s[2 * kb2][1]); w.y = cvt_pk_bf16(s[2 * kb2][2], s[2 * kb2][3]);
        w.z = cvt_pk_bf16(s[2 * kb2 + 1][0], s[2 * kb2 + 1][1]); w.w = cvt_pk_bf16(s[2 * kb2 + 1][2], s[2 * kb2 + 1][3]);
        pf[kb2] = __builtin_bit_cast(bf16x8, w);
    }
}

constexpr float ATT_THR = 10.f;
template <int NDS, bool DO_MAX>
__device__ __forceinline__ void attn_core(const LAS unsigned char* Kc, const LAS unsigned char* Vc, const bf16x8 (&qf)[2][NDS], f32x4 (&oacc)[2][4], const float (&mrun)[2], f32x4 (&lsum)[2], float (&dnew)[2], int fr, int g) {
    constexpr int KP = NDS * 64 + 32, VP = 144;
    bf16x8 kf[4][NDS];
#pragma unroll
    for (int kt = 0; kt < 4; ++kt)
#pragma unroll
        for (int ds = 0; ds < NDS; ++ds) kf[kt][ds] = *(const LAS bf16x8*)(Kc + (kt * 16 + fr) * KP + ds * 64 + g * 16);
    f32x4 s0[4], s1[4];
    const f32x4 c0 = {-mrun[0], -mrun[0], -mrun[0], -mrun[0]}, c1 = {-mrun[1], -mrun[1], -mrun[1], -mrun[1]};
#pragma unroll
    for (int kt = 0; kt < 4; ++kt)
#pragma unroll
        for (int ds = 0; ds < NDS; ++ds) s0[kt] = __builtin_amdgcn_mfma_f32_16x16x32_bf16(kf[kt][ds], qf[0][ds], ds == 0 ? c0 : s0[kt], 0, 0, 0);
#pragma unroll
    for (int kt = 0; kt < 4; ++kt)
#pragma unroll
        for (int ds = 0; ds < NDS; ++ds) s1[kt] = __builtin_amdgcn_mfma_f32_16x16x32_bf16(kf[kt][ds], qf[1][ds], ds == 0 ? c1 : s1[kt], 0, 0, 0);
    bf16x8 pf0[2], pf1[2];
    attn_softmax<DO_MAX>(s0, lsum[0], dnew[0], pf0);
    attn_softmax<DO_MAX>(s1, lsum[1], dnew[1], pf1);
#pragma unroll
    for (int kb2 = 0; kb2 < 2; ++kb2)
#pragma unroll
        for (int dvt = 0; dvt < 4; ++dvt) {
            const LAS unsigned char* va = Vc + (kb2 * 32 + 4 * g + (fr >> 2)) * VP + (dvt * 16 + 4 * (fr & 3)) * 2;
            const s16x4 lo = __builtin_bit_cast(s16x4, __builtin_amdgcn_ds_read_tr16_b64_v4i16((LAS s16x4*)va));
            const s16x4 hi = __builtin_bit_cast(s16x4, __builtin_amdgcn_ds_read_tr16_b64_v4i16((LAS s16x4*)(va + 16 * VP)));
            const bf16x8 vf = (bf16x8){lo[0], lo[1], lo[2], lo[3], hi[0], hi[1], hi[2], hi[3]};
            oacc[0][dvt] = __builtin_amdgcn_mfma_f32_16x16x32_bf16(vf, pf0[kb2], oacc[0][dvt], 0, 0, 0);
            oacc[1][dvt] = __builtin_amdgcn_mfma_f32_16x16x32_bf16(vf, pf1[kb2], oacc[1][dvt], 0, 0, 0);
        }
}

template <int NDS>
__device__ __forceinline__ void attn_unit(LAS unsigned char* lds, const bf16_t* q1, const bf16_t* q2, int qpitch, const bf16_t* k1, const bf16_t* k2, int kpitch,
                                          const bf16_t* v, int vpitch, bf16_t* o, int opitch, int nkeys) {
    constexpr int KP = NDS * 64 + 32, VP = 144, KBUF = 64 * KP, VBUF = 64 * VP;
    int tid_ = threadIdx.x; asm volatile("" : "+v"(tid_));
    const int tid = tid_, lane = tid & 63, wid = tid >> 6, fr = lane & 15, g = lane >> 4;
    LAS unsigned char* Kb = lds; LAS unsigned char* Vb = lds + 4 * KBUF;
    bf16x8 qf[2][NDS];
#pragma unroll
    for (int qt = 0; qt < 2; ++qt) { const size_t ro = (size_t)(wid * 32 + qt * 16 + fr) * qpitch;
#pragma unroll
        for (int ds = 0; ds < NDS; ++ds) qf[qt][ds] = (ds < 2) ? *(const bf16x8*)(q1 + ro + ds * 32 + g * 8) : *(const bf16x8*)(q2 + ro + g * 8); }
    f32x4 oacc[2][4];
    float mrun[2], dpend[2]; f32x4 lsum[2];
#pragma unroll
    for (int qt = 0; qt < 2; ++qt) { mrun[qt] = 0.f; lsum[qt] = (f32x4){0.f, 0.f, 0.f, 0.f}; dpend[qt] = 0.f;
#pragma unroll
        for (int d = 0; d < 4; ++d) oacc[qt][d] = (f32x4){0.f, 0.f, 0.f, 0.f}; }
    const int NT = nkeys / 64;
    const int skey = tid >> 3, sch = tid & 7, skey2 = tid >> 2, sch2 = tid & 3;
    const bool two = (NDS == 3) && tid < 256;
    u32x4 ak, ak2, av, bk, bk2, bv;
#define ATT_LOAD(rk_, rk2_, rv_, t_) do { const size_t kr_ = (size_t)(t_) * 64; \
        rk_ = *(const u32x4*)(k1 + (kr_ + skey) * kpitch + sch * 8); rv_ = *(const u32x4*)(v + (kr_ + skey) * vpitch + sch * 8); \
        if (two) rk2_ = *(const u32x4*)(k2 + (kr_ + skey2) * kpitch + sch2 * 8); } while (0)
#define ATT_STORE(rk_, rk2_, rv_, nb_) do { *(LAS u32x4*)(Kb + (nb_) * KBUF + skey * KP + sch * 16) = rk_; *(LAS u32x4*)(Vb + (nb_) * VBUF + skey * VP + sch * 16) = rv_; \
        if (two) *(LAS u32x4*)(Kb + (nb_) * KBUF + skey2 * KP + 128 + sch2 * 16) = rk2_; } while (0)
    ATT_LOAD(ak, ak2, av, 0); ATT_LOAD(bk, bk2, bv, 1);
    ATT_STORE(ak, ak2, av, 0); ATT_STORE(bk, bk2, bv, 1);
    __syncthreads();
    for (int t = 0; t < NT; t += 2) {
        const int pb = (t >> 1) & 1, nb = pb ^ 1;
        const bool more = t + 2 < NT;
        if (more) { ATT_LOAD(ak, ak2, av, t + 2); ATT_LOAD(bk, bk2, bv, t + 3); }
        if (__any(__builtin_fmaxf(dpend[0], dpend[1]) > ATT_THR)) {
#pragma unroll
            for (int qt = 0; qt < 2; ++qt) {
                const float d = __builtin_fmaxf(dpend[qt], 0.f), alpha = __builtin_amdgcn_exp2f(-d);
                mrun[qt] += d; lsum[qt] *= alpha;
#pragma unroll
                for (int dv = 0; dv < 4; ++dv) oacc[qt][dv] *= alpha;
            }
        }
        float da[2], db[2];
        attn_core<NDS, true>(Kb + (2 * pb) * KBUF, Vb + (2 * pb) * VBUF, qf, oacc, mrun, lsum, da, fr, g);
        attn_core<NDS, false>(Kb + (2 * pb + 1) * KBUF, Vb + (2 * pb + 1) * VBUF, qf, oacc, mrun, lsum, db, fr, g);
        dpend[0] = __builtin_fmaxf(da[0], db[0]); dpend[1] = __builtin_fmaxf(da[1], db[1]);
        if (more) { ATT_STORE(ak, ak2, av, 2 * nb); ATT_STORE(bk, bk2, bv, 2 * nb + 1); }
        __syncthreads();
    }
#undef ATT_LOAD
#undef ATT_STORE
    { LAS unsigned char* stg = lds + wid * 4608;
#pragma unroll
      for (int qt = 0; qt < 2; ++qt) {
        const float inv = 1.f / xsum4((lsum[qt][0] + lsum[qt][1]) + (lsum[qt][2] + lsum[qt][3]));
#pragma unroll
        for (int dvt = 0; dvt < 4; ++dvt) { u32x2 w; w.x = cvt_pk_bf16(oacc[qt][dvt][0] * inv, oacc[qt][dvt][1] * inv); w.y = cvt_pk_bf16(oacc[qt][dvt][2] * inv, oacc[qt][dvt][3] * inv);
            *(LAS u32x2*)(stg + (qt * 16 + fr) * 144 + (dvt * 16 + 4 * g) * 2) = w; }
      }
      LDS_WAIT(); asm volatile("" ::: "memory");
#pragma unroll
      for (int j = 0; j < 4; ++j) { const int c = j * 64 + lane, row = c >> 3, ch = c & 7;
          const u32x4 v4 = *(const LAS u32x4*)(stg + row * 144 + ch * 16);
          *(u32x4*)(o + (size_t)(wid * 32 + row) * opitch + ch * 8) = v4; }
      LDS_WAIT(); asm volatile("" ::: "memory");
    }
}

#define GLA_LBAR() asm volatile("s_waitcnt lgkmcnt(0)\n\ts_barrier" ::: "memory")
__device__ __forceinline__ void gla_unit(const Params& p, int l, int b, int h, LAS unsigned char* lds) {
    constexpr int P144 = 144, VVP = 272, HALFB = 68864;
    int tid_ = threadIdx.x; asm volatile("" : "+v"(tid_));
    const int tid = tid_, lane = tid & 63, wid = tid >> 6, fr = lane & 15, g = lane >> 4;
    const int dir = wid >> 2, w4 = wid & 3, ht = tid & 255;
    LAS unsigned char* base = lds + dir * HALFB;
    LAS unsigned char* QD = base;
    LAS unsigned char* KD = base + 9216;
    LAS unsigned char* KE = base + 18432;
    LAS unsigned char* VV = base + 27648;
    LAS unsigned char* ST = base + 45056;
    LAS float* LRs = (LAS float*)(base + 63488);
    LAS float* SEG = (LAS float*)(base + 67584);
    LAS float* GV = (LAS float*)(base + 68608);
    const bf16_t* zb = (const bf16_t*)(p.ws + WS_ZB); const float* lrg = (const float*)(p.ws + WS_LR);
    bf16_t* ob = (bf16_t*)(p.ws + WS_HB) + 1536 + h * 128;
    const float* gout = p.in[15] + l * 128;
    const int d = ht & 63, seg = ht >> 6;
    const int lt = ht >> 2, lc = ht & 3;
    float wa[16];
#pragma unroll
    for (int r2 = 0; r2 < 16; ++r2) wa[r2] = p.in[13][(((size_t)l * 2 + dir) * 16 + r2) * 256 + h * 64 + d];
    const float ba = p.in[14][((size_t)l * 2 + dir) * 256 + h * 64 + d];
    f32x4 sreg[8];
#pragma unroll
    for (int i = 0; i < 8; ++i) sreg[i] = (f32x4){0.f, 0.f, 0.f, 0.f};
    u32x4 pq[2], pk[2], pv[4]; f32x4 plr;
#define GLA_ROW(cc_, t_) ((size_t)b * RB + ((cc_) < 4 ? 0 : NCTX) + (size_t)(dir == 0 ? (((cc_) < 4 ? (cc_) : (cc_) - 4) * 64 + (t_)) : (((cc_) < 4 ? NCTX : NLAT) - 1 - (((cc_) < 4 ? (cc_) : (cc_) - 4) * 64 + (t_)))))
#define GLA_ISSUE(cc_) do { const bf16_t* rp_ = zb + GLA_ROW(cc_, lt) * ZBP; \
        pq[0] = *(const u32x4*)(rp_ + h * 64 + lc * 16); pq[1] = *(const u32x4*)(rp_ + h * 64 + lc * 16 + 8); \
        pk[0] = *(const u32x4*)(rp_ + 256 + h * 64 + lc * 16); pk[1] = *(const u32x4*)(rp_ + 256 + h * 64 + lc * 16 + 8); \
        pv[0] = *(const u32x4*)(rp_ + 512 + h * 128 + lc * 32); pv[1] = *(const u32x4*)(rp_ + 512 + h * 128 + lc * 32 + 8); \
        pv[2] = *(const u32x4*)(rp_ + 512 + h * 128 + lc * 32 + 16); pv[3] = *(const u32x4*)(rp_ + 512 + h * 128 + lc * 32 + 24); \
        plr = *(const f32x4*)(lrg + GLA_ROW(cc_, lt) * 32 + dir * 16 + lc * 4); } while (0)
    GLA_ISSUE(0);
    for (int cc = 0; cc < 36; ++cc) {
#pragma unroll
        for (int vvt = 0; vvt < 8; ++vvt) { u32x2 w; w.x = cvt_pk_bf16(sreg[vvt][0], sreg[vvt][1]); w.y = cvt_pk_bf16(sreg[vvt][2], sreg[vvt][3]);
            *(LAS u32x2*)(ST + (vvt * 16 + fr) * P144 + (w4 * 16 + 4 * g) * 2) = w; }
        *(LAS u32x4*)(QD + lt * P144 + lc * 32) = pq[0]; *(LAS u32x4*)(QD + lt * P144 + lc * 32 + 16) = pq[1];
        *(LAS u32x4*)(KD + lt * P144 + lc * 32) = pk[0]; *(LAS u32x4*)(KD + lt * P144 + lc * 32 + 16) = pk[1];
#pragma unroll
        for (int i = 0; i < 4; ++i) *(LAS u32x4*)(VV + lt * VVP + lc * 64 + i * 16) = pv[i];
        *(LAS f32x4*)(LRs + lt * 16 + lc * 4) = plr;
        if (cc + 1 < 36) GLA_ISSUE(cc + 1);
        GLA_LBAR();
        float cb[16]; float run = 0.f;
#pragma unroll
        for (int e = 0; e < 16; ++e) { const LAS f32x4* lp = (const LAS f32x4*)(LRs + (seg * 16 + e) * 16); float lg = ba;
#pragma unroll
            for (int r4 = 0; r4 < 4; ++r4) { const f32x4 lv = lp[r4]; lg += (lv[0] * wa[4 * r4] + lv[1] * wa[4 * r4 + 1]) + (lv[2] * wa[4 * r4 + 2] + lv[3] * wa[4 * r4 + 3]); }
            const float ls = fminf(lg, 0.f) - __logf(1.f + __expf(-fabsf(lg)));
            run += ls * (1.f / 16.f); cb[e] = run; }
        SEG[seg * 64 + d] = run;
        GLA_LBAR();
        float pre = 0.f, tot = 0.f;
#pragma unroll
        for (int s2 = 0; s2 < 4; ++s2) { const float v2 = SEG[s2 * 64 + d]; tot += v2; if (s2 < seg) pre += v2; }
        float ke[16];
#pragma unroll
        for (int e = 0; e < 16; ++e) { const float bb = pre + cb[e]; const int t = seg * 16 + e;
            LAS unsigned short* qp = (LAS unsigned short*)(QD + t * P144 + d * 2); LAS unsigned short* kp = (LAS unsigned short*)(KD + t * P144 + d * 2);
            const float qv = bf2f(*qp), kv = bf2f(*kp);
            const float qd = qv * 0.125f * __expf(bb), kd = kv * __expf(-bb); ke[e] = kv * __expf(tot - bb);
            *qp = (unsigned short)(cvt_pk_bf16(qd, 0.f) & 0xffffu); *kp = (unsigned short)(cvt_pk_bf16(kd, 0.f) & 0xffffu); }
        { u32x4 w; w.x = cvt_pk_bf16(ke[0], ke[1]); w.y = cvt_pk_bf16(ke[2], ke[3]); w.z = cvt_pk_bf16(ke[4], ke[5]); w.w = cvt_pk_bf16(ke[6], ke[7]);
          *(LAS u32x4*)(KE + d * P144 + seg * 32) = w;
          w.x = cvt_pk_bf16(ke[8], ke[9]); w.y = cvt_pk_bf16(ke[10], ke[11]); w.z = cvt_pk_bf16(ke[12], ke[13]); w.w = cvt_pk_bf16(ke[14], ke[15]);
          *(LAS u32x4*)(KE + d * P144 + seg * 32 + 16) = w; }
        if (seg == 0) GV[d] = __expf(tot);
        GLA_LBAR();
        const int it = w4;
        bf16x8 qfr[2];
#pragma unroll
        for (int ds = 0; ds < 2; ++ds) qfr[ds] = *(const LAS bf16x8*)(QD + (it * 16 + fr) * P144 + ds * 64 + g * 16);
        f32x4 T[4];
#pragma unroll
        for (int jt = 0; jt < 4; ++jt) {
            T[jt] = (f32x4){0.f, 0.f, 0.f, 0.f};
            if (jt <= it) {
#pragma unroll
                for (int ds = 0; ds < 2; ++ds) { const bf16x8 kf = *(const LAS bf16x8*)(KD + (jt * 16 + fr) * P144 + ds * 64 + g * 16);
                    T[jt] = __builtin_amdgcn_mfma_f32_16x16x32_bf16(kf, qfr[ds], T[jt], 0, 0, 0); }
                if (jt == it) {
#pragma unroll
                    for (int e = 0; e < 4; ++e) if (4 * g + e > fr) T[jt][e] = 0.f;
                }
            }
        }
        bf16x8 pfr[2];
#pragma unroll
        for (int jb = 0; jb < 2; ++jb) { u32x4 w; w.x = cvt_pk_bf16(T[2 * jb][0], T[2 * jb][1]); w.y = cvt_pk_bf16(T[2 * jb][2], T[2 * jb][3]);
            w.z = cvt_pk_bf16(T[2 * jb + 1][0], T[2 * jb + 1][1]); w.w = cvt_pk_bf16(T[2 * jb + 1][2], T[2 * jb + 1][3]); pfr[jb] = __builtin_bit_cast(bf16x8, w); }
        const int cin = cc < 4 ? cc : cc - 4; const int other = cc < 4 ? 3 - cin : 35 - cin; const bool second = cc > other;
        const size_t orow = GLA_ROW(cc, it * 16 + fr);
        unsigned long long part[8]; u32x2 gts[8];
        if (second) {
#pragma unroll
            for (int vvt = 0; vvt < 8; ++vvt) { part[vvt] = __hip_atomic_load((const unsigned long long*)(ob + orow * HBP + vvt * 16 + 4 * g), __ATOMIC_RELAXED, __HIP_MEMORY_SCOPE_AGENT);
                gts[vvt] = *(const u32x2*)(zb + orow * ZBP + 1024 + h * 128 + vvt * 16 + 4 * g); }
        }
        f32x4 oacc[8];
        const f32x4 gd = *(const LAS f32x4*)(GV + it * 16 + 4 * g);
#pragma unroll
        for (int vvt = 0; vvt < 8; ++vvt) {
            oacc[vvt] = (f32x4){0.f, 0.f, 0.f, 0.f};
#pragma unroll
            for (int jb = 0; jb < 2; ++jb) {
                if (2 * jb <= it) {
                    const LAS unsigned char* va = VV + (jb * 32 + 4 * g + (fr >> 2)) * VVP + (vvt * 16 + 4 * (fr & 3)) * 2;
                    const s16x4 lo = __builtin_bit_cast(s16x4, __builtin_amdgcn_ds_read_tr16_b64_v4i16((LAS s16x4*)va));
                    const s16x4 hi = __builtin_bit_cast(s16x4, __builtin_amdgcn_ds_read_tr16_b64_v4i16((LAS s16x4*)(va + 16 * VVP)));
                    const bf16x8 vf = (bf16x8){lo[0], lo[1], lo[2], lo[3], hi[0], hi[1], hi[2], hi[3]};
                    oacc[vvt] = __builtin_amdgcn_mfma_f32_16x16x32_bf16(vf, pfr[jb], oacc[vvt], 0, 0, 0);
                }
            }
#pragma unroll
            for (int ds = 0; ds < 2; ++ds) { const bf16x8 sf = *(const LAS bf16x8*)(ST + (vvt * 16 + fr) * P144 + ds * 64 + g * 16);
                oacc[vvt] = __builtin_amdgcn_mfma_f32_16x16x32_bf16(sf, qfr[ds], oacc[vvt], 0, 0, 0); }
            sreg[vvt] = sreg[vvt] * gd;
#pragma unroll
            for (int jb = 0; jb < 2; ++jb) {
                const bf16x8 kef = *(const LAS bf16x8*)(KE + (it * 16 + fr) * P144 + (jb * 32 + 8 * g) * 2);
                const LAS unsigned char* va = VV + (jb * 32 + 8 * g + (fr >> 2)) * VVP + (vvt * 16 + 4 * (fr & 3)) * 2;
                const s16x4 lo = __builtin_bit_cast(s16x4, __builtin_amdgcn_ds_read_tr16_b64_v4i16((LAS s16x4*)va));
                const s16x4 hi = __builtin_bit_cast(s16x4, __builtin_amdgcn_ds_read_tr16_b64_v4i16((LAS s16x4*)(va + 4 * VVP)));
                const bf16x8 vf = (bf16x8){lo[0], lo[1], lo[2], lo[3], hi[0], hi[1], hi[2], hi[3]};
                sreg[vvt] = __builtin_amdgcn_mfma_f32_16x16x32_bf16(kef, vf, sreg[vvt], 0, 0, 0);
            }
        }
        if (!second) {
#pragma unroll
            for (int vvt = 0; vvt < 8; ++vvt) { u32x2 w; w.x = cvt_pk_bf16(oacc[vvt][0], oacc[vvt][1]); w.y = cvt_pk_bf16(oacc[vvt][2], oacc[vvt][3]);
                *(u32x2*)(ob + orow * HBP + vvt * 16 + 4 * g) = w; }
        } else {
            float sq = 0.f;
#pragma unroll
            for (int vvt = 0; vvt < 8; ++vvt) { const unsigned long long pv2 = part[vvt];
                oacc[vvt][0] += bflo((unsigned)pv2); oacc[vvt][1] += bfhi((unsigned)pv2); oacc[vvt][2] += bflo((unsigned)(pv2 >> 32)); oacc[vvt][3] += bfhi((unsigned)(pv2 >> 32));
                sq += (oacc[vvt][0] * oacc[vvt][0] + oacc[vvt][1] * oacc[vvt][1]) + (oacc[vvt][2] * oacc[vvt][2] + oacc[vvt][3] * oacc[vvt][3]); }
            sq += __shfl_xor(sq, 16); sq += __shfl_xor(sq, 32);
            const float rs = rsqrtf(sq * (1.f / 128.f) + EPS);
#pragma unroll
            for (int vvt = 0; vvt < 8; ++vvt) { const int vv = vvt * 16 + 4 * g; const f32x4 go = *(const f32x4*)(gout + vv);
                const float g0 = bflo(gts[vvt].x), g1 = bfhi(gts[vvt].x), g2 = bflo(gts[vvt].y), g3 = bfhi(gts[vvt].y);
                const float r0 = oacc[vvt][0] * rs * go[0] * (g0 * __builtin_amdgcn_rcpf(1.f + __expf(-g0))), r1 = oacc[vvt][1] * rs * go[1] * (g1 * __builtin_amdgcn_rcpf(1.f + __expf(-g1)));
                const float r2 = oacc[vvt][2] * rs * go[2] * (g2 * __builtin_amdgcn_rcpf(1.f + __expf(-g2))), r3 = oacc[vvt][3] * rs * go[3] * (g3 * __builtin_amdgcn_rcpf(1.f + __expf(-g3)));
                u32x2 w; w.x = cvt_pk_bf16(r0, r1); w.y = cvt_pk_bf16(r2, r3);
                *(u32x2*)(ob + orow * HBP + vv) = w; }
        }
        asm volatile("s_waitcnt vmcnt(0) lgkmcnt(0)\n\ts_barrier" ::: "memory");
    }
#undef GLA_ROW
#undef GLA_ISSUE
}

__device__ __forceinline__ void phase_mix(const Params& p, int l, const Ctx& C, unsigned* counter, int which = 7) {
    LAS unsigned* bc = (LAS unsigned*)(C.lds + 147392);
    const int nctx = (l == 0) ? 128 : 0, per = 1024 + nctx, total = 64 + 2 * per;
    bf16_t* za = (bf16_t*)(p.ws + WS_ZA); bf16_t* mb = (bf16_t*)(p.ws + WS_MB); bf16_t* hb = (bf16_t*)(p.ws + WS_HB);
    for (;;) {
        if (C.tid == 0) *bc = atomicAdd(counter, 1u);
        __syncthreads();
        int u = (int)*bc;
        __syncthreads();
        if (u >= total) break;
        if (u < 64) { if (which & 1) gla_unit(p, l, u >> 2, u & 3, C.lds); }
        else {
            u -= 64; int kind, b, head, qt; bool isctx;
            if (u < 2048) { kind = u < 1024 ? 1 : 0; u &= 1023; b = u >> 6; head = (u >> 3) & 7; qt = u & 7; isctx = false; }
            else { u -= 2048; kind = u >= 128; u &= 127; b = u >> 3; head = u & 7; qt = 0; isctx = true; }
            if (!((which >> (1 + kind)) & 1)) continue;
            const size_t q0 = (size_t)b * RB + (isctx ? 0 : NCTX + qt * 256), k0 = (size_t)b * RB; const int nkeys = isctx ? NCTX : RB;
            if (kind == 0) { const int kvh = head >> 2;
                attn_unit<2>(C.lds, za + q0 * ZAP + head * 64, nullptr, ZAP, za + k0 * ZAP + 512 + kvh * 64, nullptr, ZAP, za + k0 * ZAP + 640 + kvh * 64, ZAP, hb + q0 * HBP + 1024 + head * 64, HBP, nkeys); }
            else { attn_unit<3>(C.lds, mb + q0 * MBP + 1024 + head * 64, mb + q0 * MBP + 1536 + head * 32, MBP, mb + k0 * MBP + head * 64, mb + k0 * MBP + 1792, MBP, mb + k0 * MBP + 512 + head * 64, MBP,
                               mb + q0 * MBP + 1024 + head * 64, MBP, nkeys); }
        }
        __syncthreads();
    }
}

constexpr int LDS_BYTES = 147456;
#ifndef PH_MASK
#define PH_MASK 0xFFFF
#endif
#define PH(k) ((PH_MASK >> (k)) & 1)
#ifndef REP_MASK
#define REP_MASK 0
#endif
#define REPS(k) (1 + ((REP_MASK >> (k)) & 1))
typedef const __attribute__((address_space(4))) Params KParams;
__device__ __forceinline__ Params load_params() {
    Params r{};
#if defined(__HIP_DEVICE_COMPILE__)
    KParams* k = (KParams*)__builtin_amdgcn_kernarg_segment_ptr(); asm volatile("" : "+s"(k));
#pragma unroll
    for (int i = 0; i < 24; ++i) r.in[i] = k->in[i];
    r.out = k->out; r.ws = k->ws;
#endif
    return r;
}
__global__ void __launch_bounds__(512, 2) fwd_kernel(Params p_unused) {
    extern __shared__ __attribute__((aligned(16))) unsigned char smem[];
    cg::grid_group grid = cg::this_grid();
    unsigned bgen = 0; (void)bgen;
    volatile LAS unsigned* xst = (volatile LAS unsigned*)((LAS unsigned char*)smem + 147200);
    if (threadIdx.x == 0) { xst[0] = 0u; xst[1] = 0u; }
    const unsigned xcc = xb_xcc_id();
#define XBAR_WORDS ((unsigned*)(((const KParams*)__builtin_amdgcn_kernarg_segment_ptr())->ws + WS_CTL) + 4096)
    if (threadIdx.x == 0) (void)xb_add(&XBAR_WORDS[XB_XCNT(xcc)], 1u);
    __syncthreads();
#define GBAR() xcd_barrier(XBAR_WORDS, xcc, xst)
#define PHASE_ENV \
    Params p = load_params(); \
    Ctx C; { int t_ = threadIdx.x; asm volatile("" : "+v"(t_)); int b_ = blockIdx.x; asm volatile("" : "+s"(b_)); C.tid = t_; C.lane = t_ & 63; C.wave = __builtin_amdgcn_readfirstlane(t_ >> 6); \
      C.gw = b_ * 8 + C.wave; C.ngw = gridDim.x * 8; C.lds = (LAS unsigned char*)smem; } \
    unsigned char* ws = p.ws; unsigned* ctl = (unsigned*)(ws + WS_CTL); float* mod = (float*)(ws + WS_MOD); float* stats = (float*)(ws + WS_STATS); \
    bf16_t* hb = (bf16_t*)(ws + WS_HB); float* xc = (float*)(ws + WS_XC); const int G = gridDim.x; const int cblk = C.gw >> 3; \
    (void)ctl; (void)mod; (void)stats; (void)hb; (void)xc; (void)G; (void)cblk;
    { PHASE_ENV
      if (PH(0)) phase_ada(p, C); }
#ifdef PROBE_SYNC
    for (int q_ = 0; q_ < 20; ++q_) grid.sync();
#endif
#ifdef PROBE_ADA
    GBAR(); { PHASE_ENV phase_ada(p, C); }
#endif
    if (((const KParams*)__builtin_amdgcn_kernarg_segment_ptr())->out == nullptr) grid.sync();
    GBAR();
    for (int l_ = 0; l_ < 2; ++l_) {
        int l = l_; asm volatile("" : "+s"(l));
        { PHASE_ENV
        if (PH(1)) convert_group1(p, l, C);
        if (PH(2)) { RowArgs a;
          a.x_lat = l == 0 ? p.in[0] : p.out; a.x_ctx = l == 0 ? p.in[2] : xc; a.xo_lat = l == 0 ? nullptr : p.out; a.xo_ctx = l == 0 ? nullptr : xc;
          a.delta = l == 0 ? nullptr : hb + 1024; a.dstats = stats; a.gpost = p.in[9]; a.modg = mod; a.gate_idx = 5;
          a.gpre = p.in[6] + l * 1024; a.modh = mod + (size_t)l * 17 * 6144; a.sh_idx = 0; a.sc_idx = 1; a.hout = hb; a.skip_ctx = 0;
          phase_rows(a, C); } }
        GBAR();
        for (int rep_ = 0; rep_ < REPS(3); ++rep_) { if (rep_) GBAR(); PHASE_ENV Sched S; S.A = (const char*)hb; S.B = (const char*)(ws + WS_WIN); S.a_tile = (size_t)256 * HBP * 2; S.b_tile = (size_t)256 * 1024 * 2; S.nM = 144; S.nN = 12; S.nt = 16; S.G = G; S.c = cblk; S.mode = 0; S.skip_ctx = 0; S.A2 = S.A3 = S.A4 = nullptr;
          EpiStore<0> E{ws, nullptr, 0, stats};
          pg8::gemm_phase(C.lds, HBP, 1024, S, E); }
        GBAR();
        for (int rep_ = 0; rep_ < REPS(4); ++rep_) { if (rep_) GBAR(); PHASE_ENV Sched S; S.A = (const char*)(hb + 1024); S.A2 = (const char*)(hb + 1408); S.B = (const char*)(ws + WS_WUQ); S.A3 = (const char*)(ws + WS_WUKV); S.A4 = nullptr;
          S.a_tile = (size_t)256 * HBP * 2; S.b_tile = (size_t)256 * 384 * 2; S.nM = 144; S.nN = 7; S.nt = 6; S.G = G; S.c = cblk; S.mode = 1; S.skip_ctx = 0;
          EpiUp E{ws};
          pg8::gemm_phase(C.lds, HBP, 384, S, E); }
        if (PH(5)) { PHASE_ENV phase_prep(p, l, C); }
        GBAR();
        if (PH(6)) { PHASE_ENV phase_mix(p, l, C, ctl + 64 * l); }
#if (REP_MASK >> 6) & 1
        GBAR(); { PHASE_ENV phase_mix(p, l, C, ctl + 64 * (2 + l), 3); }
#endif
        GBAR();
        for (int rep_ = 0; rep_ < REPS(7); ++rep_) { if (rep_) GBAR(); PHASE_ENV Sched S; S.A = (const char*)hb; S.A2 = (const char*)(hb + 1024); S.A3 = (const char*)(hb + 1536); S.A4 = (const char*)((bf16_t*)(ws + WS_MB) + 1024); S.B = (const char*)(ws + WS_WMG);
          S.a_tile = (size_t)256 * HBP * 2; S.b_tile = 0; S.nM = l == 0 ? 144 : 128; S.nN = 4; S.nt = 16; S.G = G; S.c = cblk; S.mode = 2; S.skip_ctx = l;
          EpiMerge E{ws};
          pg8::gemm_phase(C.lds, HBP, 1536, S, E); }
        GBAR();
        for (int rep_ = 0; rep_ < REPS(8); ++rep_) { if (rep_) GBAR(); PHASE_ENV Sched S; S.A = (const char*)(ws + WS_MB); S.B = (const char*)(ws + WS_WOUT); S.a_tile = (size_t)256 * MBP * 2; S.b_tile = (size_t)256 * 1024 * 2; S.nM = l == 0 ? 144 : 128; S.nN = 4; S.nt = 16; S.G = G; S.c = cblk; S.mode = 0; S.skip_ctx = l; S.A2 = S.A3 = S.A4 = nullptr;
          EpiStore<1> E{ws, hb + 1024, HBP, stats};
          pg8::gemm_phase(C.lds, MBP, 1024, S, E); }
        GBAR();
        { PHASE_ENV
        if (PH(9)) convert_group2(p, l, C);
        if (PH(10)) { RowArgs a;
          a.x_lat = l == 0 ? p.in[0] : p.out; a.x_ctx = l == 0 ? p.in[2] : xc; a.xo_lat = p.out; a.xo_ctx = xc;
          a.delta = hb + 1024; a.dstats = stats; a.gpost = p.in[7] + l * 1024; a.modg = mod + (size_t)l * 17 * 6144; a.gate_idx = 2;
          a.gpre = p.in[8] + l * 1024; a.modh = mod + (size_t)l * 17 * 6144; a.sh_idx = 3; a.sc_idx = 4; a.hout = hb; a.skip_ctx = l;
          phase_rows(a, C); } }
        GBAR();
        for (int rep_ = 0; rep_ < REPS(11); ++rep_) { if (rep_) GBAR(); PHASE_ENV Sched S; S.A = (const char*)hb; S.B = (const char*)(ws + WS_WM1); S.a_tile = (size_t)256 * HBP * 2; S.b_tile = (size_t)256 * 1024 * 2; S.nM = l == 0 ? 144 : 128; S.nN = 16; S.nt = 16; S.G = G; S.c = cblk; S.mode = 0; S.skip_ctx = l; S.A2 = S.A3 = S.A4 = nullptr;
          EpiStore<2> E{ws, (bf16_t*)(ws + WS_HID), HIDP, nullptr};
          pg8::gemm_phase(C.lds, HBP, 1024, S, E); }
        GBAR();
        for (int rep_ = 0; rep_ < REPS(12); ++rep_) { if (rep_) GBAR(); PHASE_ENV Sched S; S.A = (const char*)(ws + WS_HID); S.B = (const char*)(ws + WS_WM2); S.a_tile = (size_t)256 * HIDP * 2; S.b_tile = (size_t)256 * 4096 * 2; S.nM = l == 0 ? 144 : 128; S.nN = 4; S.nt = 64; S.G = G; S.c = cblk; S.mode = 0; S.skip_ctx = l; S.A2 = S.A3 = S.A4 = nullptr;
          EpiStore<1> E{ws, hb + 1024, HBP, stats};
          pg8::gemm_phase(C.lds, HIDP, 4096, S, E); }
        GBAR();
    }
    if (PH(13)) { PHASE_ENV RowArgs a;
      a.x_lat = p.out; a.x_ctx = xc; a.xo_lat = p.out; a.xo_ctx = nullptr;
      a.delta = hb + 1024; a.dstats = stats; a.gpost = p.in[9] + 1024; a.modg = mod + (size_t)17 * 6144; a.gate_idx = 5;
      a.gpre = nullptr; a.modh = nullptr; a.sh_idx = 0; a.sc_idx = 0; a.hout = nullptr; a.skip_ctx = 1;
      phase_rows(a, C); }
}

extern "C" void kernel_launch(void* const* d_in, const int* in_sizes, int n_in, void* d_out, int out_size, void* d_ws, size_t ws_size, hipStream_t stream) {
    static int grid = 0;
    if (grid == 0) {
        if (n_in != 24 || ws_size < WS_END) { fprintf(stderr, "kernel_launch: unexpected n_in %d or ws_size %zu (need %zu)\n", n_in, ws_size, (size_t)WS_END); grid = -1; return; }
        int dev = 0, cus = 0, per_cu = 0;
        (void)hipGetDevice(&dev);
        (void)hipDeviceGetAttribute(&cus, hipDeviceAttributeMultiprocessorCount, dev);
        (void)hipFuncSetAttribute((const void*)fwd_kernel, hipFuncAttributeMaxDynamicSharedMemorySize, LDS_BYTES);
        (void)hipOccupancyMaxActiveBlocksPerMultiprocessor(&per_cu, (const void*)fwd_kernel, 512, LDS_BYTES);
        if (per_cu < 1) { fprintf(stderr, "kernel_launch: occupancy query says %d blocks per CU\n", per_cu); per_cu = 1; }
        (void)hipGetLastError();
        grid = cus * 1;
    }
    if (grid < 0) return;
    Params p{};
    for (int i = 0; i < 24; ++i) p.in[i] = (const float*)d_in[i];
    p.out = (float*)d_out; p.ws = (unsigned char*)d_ws;
    (void)hipMemsetAsync((char*)d_ws + WS_CTL, 0, 65536, stream);
    void* args[] = {&p};
    hipError_t e = hipLaunchCooperativeKernel((const void*)fwd_kernel, dim3(grid), dim3(512), args, LDS_BYTES, stream);
    if (e != hipSuccess) fprintf(stderr, "cooperative launch failed: %s (grid %d)\n", hipGetErrorString(e), grid);
}
```
